# Optimizing an MI355X kernel written in HIP

```python
import jax, jax.numpy as jnp
from jax import lax
import numpy as np

D_MODEL = 2048
BATCH = 4
SEQ = 4096
DEPTH = 1

GRID_W = 64
CTX_LEN = 256
EPS = 1e-6
ATTN_HEADS = 8
ATTN_KV_HEADS = 2
HEAD_DIM = 128
Q_BLOCK = 128
ROPE_BASE = 10000.0
RET_HEADS = 8
RET_DK = 128
RET_DV = 256
RET_CHUNK = 128
PEER_HEADS = 8
PEER_N_KEYS = 128
PEER_N_EXPERTS = PEER_N_KEYS * PEER_N_KEYS
PEER_D_HALF = 128
PEER_TOPK = 16
PEER_BLOCK = 128
ATTN_Q_W = ATTN_HEADS * HEAD_DIM
ATTN_KV_W = ATTN_KV_HEADS * HEAD_DIM
RET_QK_W = RET_HEADS * RET_DK
RET_V_W = RET_HEADS * RET_DV
IN_SPLITS = (ATTN_Q_W, ATTN_KV_W, ATTN_KV_W, RET_QK_W, RET_QK_W, RET_V_W, RET_V_W, D_MODEL, D_MODEL)
IN_WIDTH = ATTN_Q_W + 2 * ATTN_KV_W + 2 * RET_QK_W + 2 * RET_V_W + 2 * D_MODEL

kernel_name = 'hybrid_gqa_retention_peer_block'


def rms_norm(x, w):
    xf = x.astype(jnp.float32)
    y = xf * lax.rsqrt(jnp.mean(xf * xf, axis=-1, keepdims=True) + EPS)
    return (y * w.astype(jnp.float32)).astype(x.dtype)


def modulate(h, shift, scale):
    return h * (1.0 + scale[:, None, :]) + shift[:, None, :]


def axial_rope_tables(length):
    t = jnp.arange(length, dtype=jnp.int32)
    row = (t // GRID_W).astype(jnp.float32)
    col = (t % GRID_W).astype(jnp.float32)
    n_freq = HEAD_DIM // 4
    inv_freq = ROPE_BASE ** (-jnp.arange(n_freq, dtype=jnp.float32) / n_freq)
    ang = jnp.concatenate([row[:, None] * inv_freq, col[:, None] * inv_freq], axis=-1)
    return jnp.cos(ang), jnp.sin(ang)


def apply_rope(x, cos, sin):
    x1, x2 = jnp.split(x, 2, axis=-1)
    cs = cos[None, :, None, :].astype(x.dtype)
    sn = sin[None, :, None, :].astype(x.dtype)
    return jnp.concatenate([x1 * cs - x2 * sn, x2 * cs + x1 * sn], axis=-1)


def split_heads(a, n_heads):
    return a.reshape(a.shape[0], a.shape[1], n_heads, a.shape[2] // n_heads)


def split_projection(p):
    points = np.cumsum(IN_SPLITS)[:-1].tolist()
    return jnp.split(p, points, axis=-1)


def gqa_block(q, k, v):
    b, lq, h, dh = q.shape
    kvh = k.shape[2]
    qg = q.reshape(b, lq, kvh, h // kvh, dh)
    s = jnp.einsum('bqkgd,bskd->bkgqs', qg, k).astype(jnp.float32) * (dh ** -0.5)
    p = jax.nn.softmax(s, axis=-1).astype(v.dtype)
    o = jnp.einsum('bkgqs,bskd->bqkgd', p, v)
    return o.reshape(b, lq, h * dh)


def latent_attention(q, k_all, v_all):
    b, l, h, dh = q.shape
    nb = l // Q_BLOCK
    qb = q.reshape(b, nb, Q_BLOCK, h, dh).transpose(1, 0, 2, 3, 4)
    o = lax.map(lambda qblk: gqa_block(qblk, k_all, v_all), qb)
    return o.transpose(1, 0, 2, 3).reshape(b, l, h * dh)


def retention_chunked(q, k, v, log_gamma, s0):
    b, l, h, _ = q.shape
    dv = v.shape[-1]
    nc = l // RET_CHUNK
    pos = jnp.arange(RET_CHUNK, dtype=jnp.float32)
    diff = pos[:, None] - pos[None, :]
    intra = jnp.where(diff >= 0, jnp.exp(log_gamma[:, None, None] * jnp.maximum(diff, 0.0)), 0.0)
    q_decay = jnp.exp(log_gamma[:, None] * (pos + 1.0)).T
    k_decay = jnp.exp(log_gamma[:, None] * (RET_CHUNK - 1.0 - pos))
    chunk_decay = jnp.exp(log_gamma * RET_CHUNK)

    def to_chunks(a):
        return a.reshape(b, nc, RET_CHUNK, h, a.shape[-1]).transpose(1, 0, 2, 3, 4)

    def step(state, chunk):
        qc, kc, vc = chunk
        s = jnp.einsum('bqhd,bkhd->bhqk', qc, kc) * intra[None]
        inner = jnp.einsum('bhqk,bkhv->bqhv', s, vc)
        cross = jnp.einsum('bqhd,bhdv->bqhv', qc, state) * q_decay[None, :, :, None]
        state = state * chunk_decay[None, :, None, None] + jnp.einsum('bkhd,hk,bkhv->bhdv', kc, k_decay, vc)
        return state, inner + cross

    _, out = lax.scan(step, s0, (to_chunks(q), to_chunks(k), to_chunks(v)))
    return out.transpose(1, 0, 2, 3, 4).reshape(b, l, h, dv)


def retention_final_state(k, v, log_gamma):
    l = k.shape[1]
    w = jnp.exp(log_gamma[:, None] * (l - 1.0 - jnp.arange(l, dtype=jnp.float32)))
    return jnp.einsum('blhd,hl,blhv->bhdv', k, w, v)


def retention_bidir(q, k, v, lg_f, lg_b, s0_f, s0_b):
    o_f = retention_chunked(q, k, v, lg_f, s0_f)
    o_b = retention_chunked(jnp.flip(q, 1), jnp.flip(k, 1), jnp.flip(v, 1), lg_b, s0_b)
    return o_f + jnp.flip(o_b, 1)


def head_norm(o, w):
    mu = jnp.mean(o, axis=-1, keepdims=True)
    var = jnp.mean(jnp.square(o - mu), axis=-1, keepdims=True)
    return (o - mu) * lax.rsqrt(var + EPS) * w.reshape(RET_HEADS, RET_DV).astype(jnp.float32)


def token_mixers(h, hc, cos, sin, w_in, q_norm_w, k_norm_w, ret_decay_fwd, ret_decay_bwd, ret_norm_w,
                 w_attn_branch, w_ret_branch, w_merge_out, update_ctx):
    f32 = jnp.float32
    b, l, _ = h.shape
    qa, ka, va, qr, kr, vr, gr, gate_attn, gate_ret = split_projection(h @ w_in)
    qa_c, ka_c, va_c, qr_c, kr_c, vr_c, gr_c, gate_attn_c, gate_ret_c = split_projection(hc @ w_in)

    q = apply_rope(rms_norm(split_heads(qa, ATTN_HEADS), q_norm_w), cos, sin)
    k = apply_rope(rms_norm(split_heads(ka, ATTN_KV_HEADS), k_norm_w), cos, sin)
    v = split_heads(va, ATTN_KV_HEADS)
    k_c = rms_norm(split_heads(ka_c, ATTN_KV_HEADS), k_norm_w)
    v_c = split_heads(va_c, ATTN_KV_HEADS)
    attn = latent_attention(q, jnp.concatenate([k_c, k], axis=1), jnp.concatenate([v_c, v], axis=1))

    lg_f = -jnp.exp(ret_decay_fwd.astype(f32))
    lg_b = -jnp.exp(ret_decay_bwd.astype(f32))
    rq = apply_rope(split_heads(qr, RET_HEADS), cos, sin).astype(f32)
    rk = apply_rope(split_heads(kr, RET_HEADS), cos, sin).astype(f32) * (RET_DK ** -0.5)
    rv = split_heads(vr, RET_HEADS).astype(f32)
    rk_c = split_heads(kr_c, RET_HEADS).astype(f32) * (RET_DK ** -0.5)
    rv_c = split_heads(vr_c, RET_HEADS).astype(f32)
    s_f = retention_final_state(rk_c, rv_c, lg_f)
    s_b = retention_final_state(jnp.flip(rk_c, 1), jnp.flip(rv_c, 1), lg_b)
    ret = retention_bidir(rq, rk, rv, lg_f, lg_b, s_f, s_b)
    ret = jax.nn.silu(gr) * head_norm(ret, ret_norm_w).reshape(b, l, RET_V_W).astype(h.dtype)

    def merge(attn_o, ret_o, g_attn, g_ret):
        mixed = jax.nn.sigmoid(g_attn) * (attn_o @ w_attn_branch) + jax.nn.sigmoid(g_ret) * (ret_o @ w_ret_branch)
        return mixed @ w_merge_out

    y = merge(attn, ret, gate_attn, gate_ret)
    if not update_ctx:
        return y, None

    lc = hc.shape[1]
    q_c = rms_norm(split_heads(qa_c, ATTN_HEADS), q_norm_w)
    attn_c = gqa_block(q_c, k_c, v_c)
    zeros = jnp.zeros_like(s_f)
    ret_c = retention_bidir(split_heads(qr_c, RET_HEADS).astype(f32), rk_c, rv_c, lg_f, lg_b, zeros, zeros)
    ret_c = jax.nn.silu(gr_c) * head_norm(ret_c, ret_norm_w).reshape(b, lc, RET_V_W).astype(hc.dtype)
    return y, merge(attn_c, ret_c, gate_attn_c, gate_ret_c)


def peer_ffn(h, w_q, sub_keys, u, v):
    b, l, d = h.shape
    nb = (b * l) // PEER_BLOCK
    tokens = h.reshape(nb, PEER_BLOCK, d)

    def one_block(xb):
        q = (xb @ w_q).reshape(PEER_BLOCK, PEER_HEADS, 2, PEER_D_HALF)
        s = jnp.einsum('thpd,hpnd->thpn', q, sub_keys).astype(jnp.float32)
        s1, i1 = lax.top_k(s[:, :, 0], PEER_TOPK)
        s2, i2 = lax.top_k(s[:, :, 1], PEER_TOPK)
        cand_s = (s1[..., :, None] + s2[..., None, :]).reshape(PEER_BLOCK, PEER_HEADS, PEER_TOPK * PEER_TOPK)
        cand_i = (i1[..., :, None] * PEER_N_KEYS + i2[..., None, :]).reshape(PEER_BLOCK, PEER_HEADS, PEER_TOPK * PEER_TOPK)
        top_s, pos = lax.top_k(cand_s, PEER_TOPK)
        expert = jnp.take_along_axis(cand_i, pos, axis=-1)
        g = jax.nn.softmax(top_s, axis=-1)
        a = jnp.einsum('td,thkd->thk', xb, u[expert])
        act = (jax.nn.gelu(a.astype(jnp.float32)) * g).astype(xb.dtype)
        return jnp.einsum('thk,thkd->td', act, v[expert])

    return lax.map(one_block, tokens).reshape(b, l, d)


def setup_inputs(seed: int = 0) -> dict:
    key = jax.random.key(seed)
    ks = jax.random.split(key, 22)
    f32 = jnp.float32

    def nrm(k, shape, scale):
        return jax.random.normal(k, shape, f32) * scale

    def gain(k, shape):
        return 1.0 + 0.02 * jax.random.normal(k, shape, f32)

    gamma = 1.0 - 2.0 ** (-5.0 - jnp.arange(RET_HEADS, dtype=f32))
    z0 = jnp.log(-jnp.log(gamma))
    return {
        'x': nrm(ks[0], (BATCH, SEQ, D_MODEL), 1.0),
        'c': nrm(ks[1], (BATCH, D_MODEL), 1.0),
        'ctx': nrm(ks[2], (BATCH, CTX_LEN, D_MODEL), 1.0),
        'c_ctx': nrm(ks[3], (D_MODEL,), 1.0),
        'ada_w': nrm(ks[4], (DEPTH, D_MODEL, 6 * D_MODEL), 0.5 * D_MODEL ** -0.5),
        'ada_b': nrm(ks[5], (DEPTH, 6 * D_MODEL), 0.02),
        'norm1_w': gain(ks[6], (DEPTH, D_MODEL)),
        'w_in': nrm(ks[7], (DEPTH, D_MODEL, IN_WIDTH), D_MODEL ** -0.5),
        'q_norm_w': gain(ks[8], (DEPTH, HEAD_DIM)),
        'k_norm_w': gain(ks[9], (DEPTH, HEAD_DIM)),
        'ret_decay_fwd': z0 + 0.05 * jax.random.normal(ks[10], (DEPTH, RET_HEADS), f32),
        'ret_decay_bwd': z0 + 0.05 * jax.random.normal(ks[11], (DEPTH, RET_HEADS), f32),
        'ret_norm_w': gain(ks[12], (DEPTH, RET_V_W)),
        'w_attn_branch': nrm(ks[13], (DEPTH, ATTN_Q_W, D_MODEL), ATTN_Q_W ** -0.5),
        'w_ret_branch': nrm(ks[14], (DEPTH, RET_V_W, D_MODEL), RET_V_W ** -0.5),
        'w_merge_out': nrm(ks[15], (DEPTH, D_MODEL, D_MODEL), D_MODEL ** -0.5),
        'norm2_w': gain(ks[16], (DEPTH, D_MODEL)),
        'peer_w_q': nrm(ks[17], (DEPTH, D_MODEL, PEER_HEADS * 2 * PEER_D_HALF), D_MODEL ** -0.5),
        'peer_keys': nrm(ks[18], (DEPTH, PEER_HEADS, 2, PEER_N_KEYS, PEER_D_HALF), PEER_D_HALF ** -0.5),
        'peer_u': nrm(ks[19], (DEPTH, PEER_N_EXPERTS, D_MODEL), D_MODEL ** -0.5),
        'peer_v': nrm(ks[20], (DEPTH, PEER_N_EXPERTS, D_MODEL), 1.0),
        'norm_f_w': gain(ks[21], (D_MODEL,)),
    }


def reference(x, c, ctx, c_ctx, ada_w, ada_b, norm1_w, w_in, q_norm_w, k_norm_w, ret_decay_fwd, ret_decay_bwd,
              ret_norm_w, w_attn_branch, w_ret_branch, w_merge_out, norm2_w, peer_w_q, peer_keys, peer_u, peer_v,
              norm_f_w):
    cos, sin = axial_rope_tables(x.shape[1])
    xc = ctx
    for layer in range(DEPTH):
        update_ctx = layer + 1 < DEPTH
        mod_x = jnp.split(jax.nn.silu(c) @ ada_w[layer] + ada_b[layer], 6, axis=-1)
        mod_c = jnp.split(jax.nn.silu(c_ctx)[None, :] @ ada_w[layer] + ada_b[layer], 6, axis=-1)

        h = modulate(rms_norm(x, norm1_w[layer]), mod_x[0], mod_x[1])
        hc = modulate(rms_norm(xc, norm1_w[layer]), mod_c[0], mod_c[1])
        y, yc = token_mixers(h, hc, cos, sin, w_in[layer], q_norm_w[layer], k_norm_w[layer],
                             ret_decay_fwd[layer], ret_decay_bwd[layer], ret_norm_w[layer],
                             w_attn_branch[layer], w_ret_branch[layer], w_merge_out[layer], update_ctx)
        x = x + mod_x[2][:, None, :] * y

        h2 = modulate(rms_norm(x, norm2_w[layer]), mod_x[3], mod_x[4])
        x = x + mod_x[5][:, None, :] * peer_ffn(h2, peer_w_q[layer], peer_keys[layer], peer_u[layer], peer_v[layer])

        if update_ctx:
            xc = xc + mod_c[2][:, None, :] * yc
            hc2 = modulate(rms_norm(xc, norm2_w[layer]), mod_c[3], mod_c[4])
            xc = xc + mod_c[5][:, None, :] * peer_ffn(hc2, peer_w_q[layer], peer_keys[layer], peer_u[layer], peer_v[layer])
    return rms_norm(x, norm_f_w)
```

```cpp
#include <hip/hip_runtime.h>
#include <hip/hip_bf16.h>
#include <cstdio>
#include <cstdint>

#ifndef MK_N_LAUNCHES
#ifndef PEER_SYNC
#define PEER_SYNC 8
#endif
#ifndef UQ
#define UQ 2
#endif
#define MK_N_LAUNCHES 1
#endif

constexpr int NB = 4, SEQ = 4096, DM = 2048, LC = 256, LT = SEQ + LC  ;
constexpr int MT = NB * LT  , ML = NB * SEQ  , INW = 11776;
constexpr float EPS = 1e-6f;

#define LAS __attribute__((address_space(3)))
#define GAS __attribute__((address_space(1)))

namespace pg8 {
#define PG8_LAS __attribute__((address_space(3)))
typedef unsigned short bf16_t;
typedef short bf16x8 __attribute__((ext_vector_type(8)));
typedef float f32x4 __attribute__((ext_vector_type(4)));
typedef unsigned u32x4 __attribute__((ext_vector_type(4)));
typedef unsigned u32x2 __attribute__((ext_vector_type(2)));
typedef int i32x4 __attribute__((ext_vector_type(4)));
constexpr int BM = 256, BK = 64, HALF = 128, HTB = HALF * BK * 2, STAGE_BYTES = 8 * HTB, NXCD = 8, WGM = 8;

__host__ __device__ __forceinline__ int lds_byte(int r, int c) { const int st = (r >> 4) * 2 + (c >> 5), rr = r & 15, cc = c & 31, ob = rr * 64 + cc * 2; return st * 1024 + (ob ^ (((ob >> 9) & 1) << 5)); }
__host__ __device__ __forceinline__ void stage_rc(int b, int& R, int& C) { const int st = b / 1024, sb = b % 1024, swz = sb ^ (((sb >> 9) & 1) << 5); R = (st >> 1) * 16 + swz / 64; C = (st & 1) * 32 + (swz % 64) / 2; }
__host__ __device__ __forceinline__ int perm32(int rho) { const int n = rho >> 4, i = rho & 15; return 8 * (i >> 2) + 4 * n + (i & 3); }

struct Unit { int pm, pn; const char* a; const char* b; };
struct Gemm { int lda, ldb, K; const float* rs; float wsc; };

__device__ __forceinline__ bool static_tile(int nM, int nN, int G, int c, int i, int& pm, int& pn) {
    const int nwg = nM * nN; const long L = (long)i * G + c; if (L >= nwg) return false;
    int wgid = (int)L; { const int q = nwg / NXCD, r = nwg % NXCD, xcd = wgid % NXCD, off = wgid / NXCD; wgid = (xcd < r ? xcd * (q + 1) : r * (q + 1) + (xcd - r) * q) + off; }
    const int nig = WGM * nN, gid = wgid / nig, fm = gid * WGM, gsz = (nM - fm) < WGM ? (nM - fm) : WGM;
    pm = fm + ((wgid % nig) % gsz); pn = (wgid % nig) / gsz; return true;
}
struct PlainSched {
    int nM, nN, G, c; const char* A; const char* B; size_t ta, tb;
    __device__ __forceinline__ bool next(int i, Unit& u) const { int pm, pn; if (!static_tile(nM, nN, G, c, i, pm, pn)) return false; u.pm = pm; u.pn = pn; u.a = A + (size_t)pm * ta; u.b = B + (size_t)pn * tb; return true; }
};

typedef float f32x2c __attribute__((ext_vector_type(2))); typedef __bf16 bf16x2c __attribute__((ext_vector_type(2)));
__device__ __forceinline__ unsigned cvt_pk_bf16(float lo, float hi) { f32x2c v = {lo, hi}; bf16x2c b = __builtin_convertvector(v, bf16x2c); return __builtin_bit_cast(unsigned, b); }
__device__ __forceinline__ float bf_lo(unsigned w) { return __uint_as_float(w << 16); }
__device__ __forceinline__ float bf_hi(unsigned w) { return __uint_as_float(w & 0xffff0000u); }
__device__ __forceinline__ u32x4 pack8(f32x4 v0, f32x4 v1) { u32x4 w; w.x = cvt_pk_bf16(v0[0], v0[1]); w.y = cvt_pk_bf16(v0[2], v0[3]); w.z = cvt_pk_bf16(v1[0], v1[1]); w.w = cvt_pk_bf16(v1[2], v1[3]); return w; }
__device__ __forceinline__ float sigm(float v) { return __builtin_amdgcn_rcpf(1.0f + __expf(-v)); }
__device__ __forceinline__ unsigned q4_i8(f32x4 v) {
    const float MG = 12582912.f;
    const unsigned a = __float_as_uint(__builtin_amdgcn_fmed3f(v.x, -127.f, 127.f) + MG), b = __float_as_uint(__builtin_amdgcn_fmed3f(v.y, -127.f, 127.f) + MG);
    const unsigned c = __float_as_uint(__builtin_amdgcn_fmed3f(v.z, -127.f, 127.f) + MG), d = __float_as_uint(__builtin_amdgcn_fmed3f(v.w, -127.f, 127.f) + MG);
    return (a & 255u) | ((b & 255u) << 8) | ((c & 255u) << 16) | (d << 24);
}


struct EpiRoute {
    static constexpr bool PERM = true, AFTER_DRAIN = false;
    bf16_t *QA, *KA, *VA, *QR, *KR, *VR, *GR, *GA, *GT;
    const float* qnw_p; const float* knw_p;
    const float* cs;
    PG8_LAS float* xs;
    __device__ __forceinline__ void operator()(const f32x4 (&acc)[2][2][4][2], const Unit& u, int wr, int wc, int fr_, int fq_) const {
        int fr = fr_, fq = fq_; asm volatile("" : "+v"(fr), "+v"(fq));
        const int pn = u.pn, pm = u.pm, b = pm / 17, jt = pm % 17;
        const int rowAll = pm * 256, rowLat = (b * 16 + jt - 1) * 256;
        bf16_t* base; int ldc, row0, colt, kind = 0;
        if (pn < 4)       { base = QA; ldc = 1024; row0 = rowLat; colt = pn * 256; kind = 3; }
        else if (pn == 4) { base = KA; ldc = 256;  row0 = rowAll; colt = 0; kind = 3; }
        else if (pn == 5) { base = VA; ldc = 256;  row0 = rowAll; colt = 0; }
        else if (pn < 10) { base = QR; ldc = 1024; row0 = rowLat; colt = (pn - 6) * 256; kind = 4; }
        else if (pn < 14) { base = KR; ldc = 1024; row0 = rowAll; colt = (pn - 10) * 256; kind = jt ? 4 : 0; }
        else if (pn < 22) { base = VR; ldc = 2048; row0 = rowAll; colt = (pn - 14) * 256; }
        else if (pn < 30) { base = GR; ldc = 2048; row0 = rowLat; colt = (pn - 22) * 256; kind = 1; }
        else if (pn < 38) { base = GA; ldc = 2048; row0 = rowLat; colt = (pn - 30) * 256; kind = 2; }
        else              { base = GT; ldc = 2048; row0 = rowLat; colt = (pn - 38) * 256; kind = 2; }
        const int col0 = colt + wc * 32 + 8 * fq;
        if (kind < 3) {
#pragma unroll
            for (int ai = 0; ai < 2; ++ai)
#pragma unroll
                for (int m = 0; m < 4; ++m) { bf16_t* rowp = base + (size_t)(row0 + wr * 64 + fr + ai * HALF + m * 16) * ldc + col0;
#pragma unroll
                    for (int bj = 0; bj < 2; ++bj) { f32x4 v0 = acc[ai][bj][m][0], v1 = acc[ai][bj][m][1];
                        if (kind) {
#pragma unroll
                            for (int e = 0; e < 4; ++e) { const float s0 = sigm(v0[e]), s1 = sigm(v1[e]); v0[e] = kind == 1 ? v0[e] * s0 : s0; v1[e] = kind == 1 ? v1[e] * s1 : s1; } }
                        if (kind == 2) {
                            const float MG = 12582912.f; u32x2 w;
                            w.x = (__float_as_uint(v0[0] * 255.f + MG) & 255u) | ((__float_as_uint(v0[1] * 255.f + MG) & 255u) << 8) | ((__float_as_uint(v0[2] * 255.f + MG) & 255u) << 16) | (__float_as_uint(v0[3] * 255.f + MG) << 24);
                            w.y = (__float_as_uint(v1[0] * 255.f + MG) & 255u) | ((__float_as_uint(v1[1] * 255.f + MG) & 255u) << 8) | ((__float_as_uint(v1[2] * 255.f + MG) & 255u) << 16) | (__float_as_uint(v1[3] * 255.f + MG) << 24);
                            *(u32x2*)((unsigned char*)base + (size_t)(row0 + wr * 64 + fr + ai * HALF + m * 16) * ldc + col0 + bj * HALF) = w; }
                        else *(u32x4*)(rowp + bj * HALF) = pack8(v0, v1); } }
            return;
        }
        const bool rope = jt != 0; const int t0 = (jt - 1) * 256;
        const float sc = (pn >= 6 && pn < 10) ? 0.088388347648318440f : 1.0f;
        f32x4 w0 = {1.f, 1.f, 1.f, 1.f}, w1 = {1.f, 1.f, 1.f, 1.f};
        float invr[4];
#pragma unroll
        for (int k = 0; k < 4; ++k) invr[k] = exp2f(-(float)((16 * wc + 4 * fq + k) & 31) * (13.287712379549449f / 32.0f)) * 0.15915494309189535f;
        if (kind == 3) { const float* nw = (pn < 4 ? qnw_p : knw_p) + wc * 32 + 8 * fq; w0 = *(const f32x4*)nw; w1 = *(const f32x4*)(nw + 4);
#pragma unroll
            for (int ai = 0; ai < 2; ++ai)
#pragma unroll
                for (int m = 0; m < 4; ++m)
#pragma unroll
                    for (int bj = 0; bj < 2; ++bj) { const f32x4 v0 = acc[ai][bj][m][0], v1 = acc[ai][bj][m][1];
                        float s = ((v0[0] * v0[0] + v0[1] * v0[1]) + (v0[2] * v0[2] + v0[3] * v0[3])) + ((v1[0] * v1[0] + v1[1] * v1[1]) + (v1[2] * v1[2] + v1[3] * v1[3]));
                        s += __shfl_xor(s, 16); s += __shfl_xor(s, 32);
                        if (fq == 0) xs[(ai * HALF + wr * 64 + m * 16 + fr) * 8 + bj * 4 + wc] = s; }
            asm volatile("s_waitcnt lgkmcnt(0)" ::: "memory"); __builtin_amdgcn_s_barrier(); asm volatile("" ::: "memory");
        }
#pragma unroll
        for (int ai = 0; ai < 2; ++ai)
#pragma unroll
            for (int m = 0; m < 4; ++m) { const int r = ai * HALF + wr * 64 + m * 16 + fr; bf16_t* rowp = base + (size_t)(row0 + r) * ldc + col0;
                f32x4 ca = {1.f, 0.f, 1.f, 0.f}, cb = {1.f, 0.f, 1.f, 0.f};
                if (rope) { const int t = t0 + r; const float pos = (float)(wc < 2 ? (t >> 6) : (t & 63));
                    ca = (f32x4){__builtin_amdgcn_cosf(pos * invr[0]), __builtin_amdgcn_sinf(pos * invr[0]), __builtin_amdgcn_cosf(pos * invr[1]), __builtin_amdgcn_sinf(pos * invr[1])};
                    cb = (f32x4){__builtin_amdgcn_cosf(pos * invr[2]), __builtin_amdgcn_sinf(pos * invr[2]), __builtin_amdgcn_cosf(pos * invr[3]), __builtin_amdgcn_sinf(pos * invr[3])}; }
#pragma unroll
                for (int bj = 0; bj < 2; ++bj) { f32x4 v0 = acc[ai][bj][m][0] * w0, v1 = acc[ai][bj][m][1] * w1; float rs = sc;
                    if (kind == 3) { const f32x4 pt = *(const PG8_LAS f32x4*)(xs + r * 8 + bj * 4); rs = rsqrtf(((pt[0] + pt[1]) + (pt[2] + pt[3])) * (1.f / 128.f) + 1e-6f); }
                    const f32x4 o0 = {v0[0] * ca[0] - v0[1] * ca[1], v0[1] * ca[0] + v0[0] * ca[1], v0[2] * ca[2] - v0[3] * ca[3], v0[3] * ca[2] + v0[2] * ca[3]};
                    const f32x4 o1 = {v1[0] * cb[0] - v1[1] * cb[1], v1[1] * cb[0] + v1[0] * cb[1], v1[2] * cb[2] - v1[3] * cb[3], v1[3] * cb[2] + v1[2] * cb[3]};
                    *(u32x4*)(rowp + bj * HALF) = pack8(o0 * rs, o1 * rs); } }
    }
};
template <int MODE> struct EpiB {
    static constexpr bool PERM = true, AFTER_DRAIN = false;
    bf16_t* O; int ldc; const bf16_t* Gm; const bf16_t* Tm;
    __device__ __forceinline__ void operator()(const f32x4 (&acc)[2][2][4][2], const Unit& u, int wr, int wc, int fr, int fq) const {
        const int row0 = u.pm * BM + wr * 64 + fr, col0 = u.pn * BM + wc * 32 + 8 * fq;
#pragma unroll
        for (int ai = 0; ai < 2; ++ai)
#pragma unroll
            for (int m = 0; m < 4; ++m) { const size_t off = (size_t)(row0 + ai * HALF + m * 16) * ldc + col0;
#pragma unroll
                for (int bj = 0; bj < 2; ++bj) { f32x4 v0 = acc[ai][bj][m][0], v1 = acc[ai][bj][m][1];
                    if (MODE >= 1) { const u32x2 g = *(const u32x2*)((const unsigned char*)Gm + off + bj * HALF);
#pragma unroll
                        for (int e = 0; e < 4; ++e) { v0[e] *= (float)((g.x >> (8 * e)) & 255u) * (1.f / 255.f); v1[e] *= (float)((g.y >> (8 * e)) & 255u) * (1.f / 255.f); } }
                    if (MODE == 2) { const u32x4 t = *(const u32x4*)(Tm + off + bj * HALF);
                        v0[0] += bf_lo(t.x); v0[1] += bf_hi(t.x); v0[2] += bf_lo(t.y); v0[3] += bf_hi(t.y); v1[0] += bf_lo(t.z); v1[1] += bf_hi(t.z); v1[2] += bf_lo(t.w); v1[3] += bf_hi(t.w); }
                    *(u32x4*)(O + off + bj * HALF) = pack8(v0, v1); } }
    }
};
struct EpiX {
    static constexpr bool PERM = true, AFTER_DRAIN = false;
    bf16_t* O; const float* X; const float* mod;
    __device__ __forceinline__ void operator()(const f32x4 (&acc)[2][2][4][2], const Unit& u, int wr, int wc, int fr, int fq) const {
        const int row0 = u.pm * BM + wr * 64 + fr, col0 = u.pn * BM + wc * 32 + 8 * fq;
        const float* mp = mod + (size_t)((u.pm * BM) / SEQ) * 12288 + col0;
        f32x4 mv[2][2];
#pragma unroll
        for (int bj = 0; bj < 2; ++bj) { mv[bj][0] = *(const f32x4*)(mp + bj * HALF); mv[bj][1] = *(const f32x4*)(mp + bj * HALF + 4); }
#pragma unroll
        for (int ai = 0; ai < 2; ++ai)
#pragma unroll
            for (int m = 0; m < 4; ++m) { const size_t off = (size_t)(row0 + ai * HALF + m * 16) * 2048 + col0;
#pragma unroll
                for (int bj = 0; bj < 2; ++bj) { const f32x4 x0 = *(const f32x4*)(X + off + bj * HALF), x1 = *(const f32x4*)(X + off + bj * HALF + 4);
                    *(u32x4*)(O + off + bj * HALF) = pack8(x0 + mv[bj][0] * acc[ai][bj][m][0], x1 + mv[bj][1] * acc[ai][bj][m][1]); } }
    }
};
typedef _Float16 f16x2c __attribute__((ext_vector_type(2)));
__device__ __forceinline__ unsigned cvt_pk_f16(float lo, float hi) { f32x2c v = {lo, hi}; return __builtin_bit_cast(unsigned, __builtin_convertvector(v, f16x2c)); }
struct EpiH {
    static constexpr bool PERM = true, AFTER_DRAIN = false;
    _Float16* C; int ldc; const float* cs;
    __device__ __forceinline__ void operator()(const f32x4 (&acc)[2][2][4][2], const Unit& u, int wr, int wc, int fr, int fq) const {
        const int row0 = u.pm * BM + wr * 64 + fr, col0 = u.pn * BM + wc * 32 + 8 * fq;
        f32x4 cv[2][2];
#pragma unroll
        for (int bj = 0; bj < 2; ++bj) { cv[bj][0] = *(const f32x4*)(cs + col0 + bj * HALF); cv[bj][1] = *(const f32x4*)(cs + col0 + bj * HALF + 4); }
#pragma unroll
        for (int ai = 0; ai < 2; ++ai)
#pragma unroll
            for (int m = 0; m < 4; ++m) { const size_t off = (size_t)(row0 + ai * HALF + m * 16) * ldc + col0;
#pragma unroll
                for (int bj = 0; bj < 2; ++bj) { const f32x4 v0 = acc[ai][bj][m][0] * cv[bj][0], v1 = acc[ai][bj][m][1] * cv[bj][1];
                    u32x4 w; w.x = cvt_pk_f16(v0[0], v0[1]); w.y = cvt_pk_f16(v0[2], v0[3]); w.z = cvt_pk_f16(v1[0], v1[1]); w.w = cvt_pk_f16(v1[2], v1[3]);
                    *(u32x4*)(C + off + bj * HALF) = w; } }
    }
};
struct EpiMixQ {
    static constexpr bool PERM = true, AFTER_DRAIN = false;
    unsigned char* O; const unsigned char* Gm; const bf16_t* Tm; const float* qsm;
    __device__ __forceinline__ void operator()(const f32x4 (&acc)[2][2][4][2], const Unit& u, int wr, int wc, int fr, int fq) const {
        const int row0 = u.pm * BM + wr * 64 + fr, col0 = u.pn * BM + wc * 32 + 8 * fq;
#pragma unroll
        for (int ai = 0; ai < 2; ++ai)
#pragma unroll
            for (int m = 0; m < 4; ++m) { const int row = row0 + ai * HALF + m * 16; const size_t off = (size_t)row * 2048 + col0; const float qs = qsm[row];
#pragma unroll
                for (int bj = 0; bj < 2; ++bj) { f32x4 v0 = acc[ai][bj][m][0], v1 = acc[ai][bj][m][1];
                    const u32x2 g = *(const u32x2*)(Gm + off + bj * HALF); const u32x4 t = *(const u32x4*)(Tm + off + bj * HALF);
#pragma unroll
                    for (int e = 0; e < 4; ++e) { v0[e] *= (float)((g.x >> (8 * e)) & 255u) * (1.f / 255.f); v1[e] *= (float)((g.y >> (8 * e)) & 255u) * (1.f / 255.f); }
                    v0[0] += bf_lo(t.x); v0[1] += bf_hi(t.x); v0[2] += bf_lo(t.y); v0[3] += bf_hi(t.y); v1[0] += bf_lo(t.z); v1[1] += bf_hi(t.z); v1[2] += bf_lo(t.w); v1[3] += bf_hi(t.w);
                    u32x2 w; w.x = q4_i8(v0 * qs); w.y = q4_i8(v1 * qs); *(u32x2*)(O + off + bj * HALF) = w; } }
    }
};
template <int MODE> struct EpiF {
    static constexpr bool PERM = false, AFTER_DRAIN = false;
    float* C; int ldc; const float* X; const float* mod;
    __device__ __forceinline__ void operator()(const f32x4 (&acc)[2][2][4][2], const Unit& u, int wr, int wc, int fr, int fq) const {
        const int row0 = u.pm * BM + wr * 64 + fr, col0 = u.pn * BM + wc * 32 + 4 * fq;
        f32x4 mv[2][2];
        if (MODE == 1) { const float* mp = mod + (size_t)((u.pm * BM) / SEQ) * 12288 + col0;
#pragma unroll
            for (int bj = 0; bj < 2; ++bj)
#pragma unroll
                for (int n = 0; n < 2; ++n) mv[bj][n] = *(const f32x4*)(mp + bj * HALF + n * 16); }
#pragma unroll
        for (int ai = 0; ai < 2; ++ai)
#pragma unroll
            for (int m = 0; m < 4; ++m) { const size_t off = (size_t)(row0 + ai * HALF + m * 16) * ldc + col0;
#pragma unroll
                for (int bj = 0; bj < 2; ++bj)
#pragma unroll
                    for (int n = 0; n < 2; ++n) { f32x4 v = acc[ai][bj][m][n];
                        if (MODE == 1) v = *(const f32x4*)(X + off + bj * HALF + n * 16) + mv[bj][n] * v;
                        *(f32x4*)(C + off + bj * HALF + n * 16) = v; } }
    }
};

template <class Epi, class Sched, bool ALIGN_EPI = true, bool SP2 = true, bool I8 = false>
__device__ __forceinline__ void gemm_phase(PG8_LAS unsigned char* lds, const Gemm g, const Sched& S, const Epi& E) {
    const int tid = threadIdx.x, wid = __builtin_amdgcn_readfirstlane(tid >> 6), lane = tid & 63, wr = wid >> 2, wc = wid & 3, fr = lane & 15, fq = lane >> 4;
    const int K = g.K, nt = K / BK;
    unsigned voffA[2], voffB[2];
#pragma unroll
    for (int i = 0; i < 2; ++i) { int R, C; stage_rc(tid * 16 + i * 8192, R, C); const int Rb = Epi::PERM ? ((R & ~31) + perm32(R & 31)) : R;
        voffA[i] = (unsigned)(R * g.lda + C) * 2u; voffB[i] = (unsigned)(Rb * g.ldb + C) * 2u; }
    const size_t kstep = (size_t)(BK * 2);
    const size_t hstepA = (size_t)HALF * g.lda * 2, hstepB = (size_t)HALF * g.ldb * 2;
    const unsigned ldsw = (unsigned)wid * 1024u;
    const int aoff = lds_byte(wr * 64 + fr, fq * 8), boff = lds_byte(wc * 32 + fr, fq * 8);
#define PG8_SA(b, h) (((b) * 2 + (h)) * HTB)
#define PG8_SB(b, h) ((4 + (b) * 2 + (h)) * HTB)
#define PG8_STAGE(bufoff, gbase, voff) do { _Pragma("unroll") for (int _i = 0; _i < 2; ++_i) \
        __builtin_amdgcn_global_load_lds((const unsigned*)((const char*)(gbase) + (voff)[_i]), (PG8_LAS unsigned*)(lds + (bufoff) + ldsw + _i * 8192), 16, 0, 0); } while (0)
#define PG8_LDA(dst, b, h) do { _Pragma("unroll") for (int m = 0; m < 4; ++m) _Pragma("unroll") for (int k = 0; k < 2; ++k) dst[m][k] = *(const PG8_LAS bf16x8*)(lds + PG8_SA(b, h) + aoff + m * 2048 + k * 1024); } while (0)
#define PG8_LDB(dst, b, h) do { _Pragma("unroll") for (int n = 0; n < 2; ++n) _Pragma("unroll") for (int k = 0; k < 2; ++k) dst[n][k] = *(const PG8_LAS bf16x8*)(lds + PG8_SB(b, h) + boff + n * 2048 + k * 1024); } while (0)
#define PG8_MMA(ai, bj, At, Bt) do { __builtin_amdgcn_s_setprio(1); _Pragma("unroll") for (int m = 0; m < 4; ++m) _Pragma("unroll") for (int n = 0; n < 2; ++n) _Pragma("unroll") for (int k = 0; k < 2; ++k) { \
        if constexpr (I8) acc[ai][bj][m][n] = __builtin_bit_cast(f32x4, __builtin_amdgcn_mfma_i32_16x16x64_i8(__builtin_bit_cast(i32x4, Bt[n][k]), __builtin_bit_cast(i32x4, At[m][k]), __builtin_bit_cast(i32x4, acc[ai][bj][m][n]), 0, 0, 0)); \
        else acc[ai][bj][m][n] = __builtin_amdgcn_mfma_f32_16x16x32_bf16(Bt[n][k], At[m][k], acc[ai][bj][m][n], 0, 0, 0); } \
        __builtin_amdgcn_s_setprio(0); } while (0)
#define PG8_WAIT_V(n) asm volatile("s_waitcnt vmcnt(" #n ")" ::: "memory")
#define PG8_WAIT_L(n) asm volatile("s_waitcnt lgkmcnt(" #n ")" ::: "memory")
#define PG8_BAR __builtin_amdgcn_s_barrier()
#define PG8_SCHED __builtin_amdgcn_sched_barrier(0)
    Unit cur, nxt; int ui = 0;
    if (!S.next(0, cur)) return;
    f32x4 acc[2][2][4][2];
#pragma unroll
    for (int a = 0; a < 2; ++a)
#pragma unroll
        for (int b = 0; b < 2; ++b)
#pragma unroll
            for (int m = 0; m < 4; ++m)
#pragma unroll
                for (int n = 0; n < 2; ++n) acc[a][b][m][n] = (f32x4){0.f, 0.f, 0.f, 0.f};
    bf16x8 At[4][2], B0[2][2], B1[2][2];
    const char* cA = cur.a; const char* cB = cur.b;
    if constexpr (SP2) {
        PG8_STAGE(PG8_SB(0, 0), cB, voffB); PG8_STAGE(PG8_SB(0, 1), cB + hstepB, voffB); PG8_STAGE(PG8_SA(0, 0), cA, voffA); PG8_STAGE(PG8_SA(0, 1), cA + hstepA, voffA);
        if (wr == 1) PG8_BAR;
        PG8_WAIT_V(2); PG8_BAR;
        PG8_STAGE(PG8_SB(1, 0), cB + kstep, voffB); PG8_STAGE(PG8_SA(1, 0), cA + kstep, voffA); PG8_STAGE(PG8_SB(1, 1), cB + hstepB + kstep, voffB);
        PG8_WAIT_V(6); PG8_BAR;
    } else {
        PG8_STAGE(PG8_SB(0, 0), cB, voffB); PG8_STAGE(PG8_SA(0, 0), cA, voffA); PG8_STAGE(PG8_SB(0, 1), cB + hstepB, voffB); PG8_STAGE(PG8_SA(0, 1), cA + hstepA, voffA);
        if (wr == 1) PG8_BAR;
        PG8_WAIT_V(4); PG8_BAR;
        PG8_STAGE(PG8_SB(1, 0), cB + kstep, voffB); PG8_STAGE(PG8_SA(1, 0), cA + kstep, voffA); PG8_STAGE(PG8_SB(1, 1), cB + hstepB + kstep, voffB);
        PG8_WAIT_V(6); PG8_BAR;
    }
    for (;;) {
        const bool has_next = S.next(ui + 1, nxt);
        const char* nA = has_next ? nxt.a : cA; const char* nB = has_next ? nxt.b : cB;
        for (int t = 0; t < nt; t += 2) {
            const bool last = (t == nt - 2);
            const char* a1 = cA + (size_t)(t + 1) * kstep;
            const char* a2 = last ? nA : cA + (size_t)(t + 2) * kstep; const char* b2 = last ? nB : cB + (size_t)(t + 2) * kstep;
            const char* a3 = a2 + kstep; const char* b3 = b2 + kstep;
            if constexpr (SP2) {
            PG8_LDB(B0, 0, 0); PG8_LDB(B1, 0, 1); PG8_SCHED; PG8_LDA(At, 0, 0); PG8_STAGE(PG8_SA(1, 1), a1 + hstepA, voffA);
            PG8_WAIT_V(8); PG8_WAIT_L(0); PG8_BAR; PG8_MMA(0, 0, At, B0); PG8_MMA(0, 1, At, B1); PG8_BAR; PG8_SCHED;
            PG8_LDA(At, 0, 1); PG8_STAGE(PG8_SB(0, 0), b2, voffB); PG8_STAGE(PG8_SB(0, 1), b2 + hstepB, voffB); PG8_STAGE(PG8_SA(0, 0), a2, voffA);
            PG8_WAIT_V(8); PG8_WAIT_L(0); PG8_BAR; PG8_MMA(1, 0, At, B0); PG8_MMA(1, 1, At, B1); PG8_BAR; PG8_SCHED;
            PG8_LDB(B0, 1, 0); PG8_LDB(B1, 1, 1); PG8_SCHED; PG8_LDA(At, 1, 0); PG8_STAGE(PG8_SA(0, 1), a2 + hstepA, voffA);
            PG8_WAIT_V(8); PG8_WAIT_L(0); PG8_BAR; PG8_MMA(0, 0, At, B0); PG8_MMA(0, 1, At, B1); PG8_BAR; PG8_SCHED;
            PG8_LDA(At, 1, 1); PG8_STAGE(PG8_SB(1, 0), b3, voffB); PG8_STAGE(PG8_SB(1, 1), b3 + hstepB, voffB); PG8_STAGE(PG8_SA(1, 0), a3, voffA);
            PG8_WAIT_V(8); PG8_WAIT_L(0); PG8_BAR; PG8_MMA(1, 0, At, B0); PG8_MMA(1, 1, At, B1); PG8_BAR; PG8_SCHED;
            } else {
            PG8_LDB(B0, 0, 0); PG8_SCHED; PG8_LDA(At, 0, 0); PG8_STAGE(PG8_SA(1, 1), a1 + hstepA, voffA);
            PG8_WAIT_L(8); PG8_BAR; PG8_WAIT_L(0); PG8_MMA(0, 0, At, B0); PG8_BAR; PG8_SCHED;
            PG8_LDB(B1, 0, 1); PG8_STAGE(PG8_SB(0, 0), b2, voffB);
            PG8_BAR; PG8_WAIT_L(0); PG8_MMA(0, 1, At, B1); PG8_BAR;
            PG8_LDA(At, 0, 1); PG8_STAGE(PG8_SA(0, 0), a2, voffA);
            PG8_BAR; PG8_WAIT_L(0); PG8_MMA(1, 0, At, B0); PG8_BAR; PG8_SCHED;
            PG8_STAGE(PG8_SB(0, 1), b2 + hstepB, voffB);
            PG8_WAIT_V(6); PG8_BAR; PG8_MMA(1, 1, At, B1); PG8_BAR;
            PG8_LDB(B0, 1, 0); PG8_SCHED; PG8_LDA(At, 1, 0); PG8_STAGE(PG8_SA(0, 1), a2 + hstepA, voffA);
            PG8_WAIT_L(8); PG8_BAR; PG8_WAIT_L(0); PG8_MMA(0, 0, At, B0); PG8_BAR; PG8_SCHED;
            PG8_LDB(B1, 1, 1); PG8_STAGE(PG8_SB(1, 0), b3, voffB);
            PG8_BAR; PG8_WAIT_L(0); PG8_MMA(0, 1, At, B1); PG8_BAR;
            PG8_LDA(At, 1, 1); PG8_STAGE(PG8_SA(1, 0), a3, voffA);
            PG8_BAR; PG8_WAIT_L(0); PG8_MMA(1, 0, At, B0); PG8_BAR; PG8_SCHED;
            PG8_STAGE(PG8_SB(1, 1), b3 + hstepB, voffB);
            PG8_WAIT_V(6); PG8_BAR; PG8_MMA(1, 1, At, B1); PG8_BAR;
            }
        }
        if constexpr (ALIGN_EPI) { if (wr == 0) PG8_BAR; }
        if constexpr (I8) {
#pragma unroll
            for (int a = 0; a < 2; ++a)
#pragma unroll
                for (int m = 0; m < 4; ++m) { const float d = g.rs[cur.pm * BM + a * HALF + wr * 64 + m * 16 + fr] * g.wsc;
#pragma unroll
                    for (int b = 0; b < 2; ++b)
#pragma unroll
                        for (int n = 0; n < 2; ++n) acc[a][b][m][n] = __builtin_convertvector(__builtin_bit_cast(i32x4, acc[a][b][m][n]), f32x4) * d; } }
        E(acc, cur, wr, wc, fr, fq);
        if (!has_next) break;
#pragma unroll
        for (int a = 0; a < 2; ++a)
#pragma unroll
            for (int b = 0; b < 2; ++b)
#pragma unroll
                for (int m = 0; m < 4; ++m)
#pragma unroll
                    for (int n = 0; n < 2; ++n) acc[a][b][m][n] = (f32x4){0.f, 0.f, 0.f, 0.f};
        cur = nxt; cA = nA; cB = nB; ++ui;
        if constexpr (ALIGN_EPI) { if (wr == 1) PG8_BAR; }
    }
    PG8_WAIT_V(0);
    if constexpr (!ALIGN_EPI) { if (wr == 0) PG8_BAR; }
    PG8_BAR;
#undef PG8_SA
#undef PG8_SB
#undef PG8_STAGE
#undef PG8_LDA
#undef PG8_LDB
#undef PG8_MMA
#undef PG8_WAIT_V
#undef PG8_WAIT_L
#undef PG8_BAR
#undef PG8_SCHED
}
}

typedef unsigned short bf16_t;
typedef short bf16x8 __attribute__((ext_vector_type(8)));
typedef short s16x4 __attribute__((ext_vector_type(4)));
typedef float f32x4 __attribute__((ext_vector_type(4)));
typedef float f32x16 __attribute__((ext_vector_type(16)));
typedef float f32x2 __attribute__((ext_vector_type(2)));
typedef unsigned u32x4 __attribute__((ext_vector_type(4)));
typedef unsigned u32x2 __attribute__((ext_vector_type(2)));
typedef __bf16 bf16x2_t __attribute__((ext_vector_type(2)));
using pg8::cvt_pk_bf16; using pg8::bf_lo; using pg8::bf_hi; using pg8::sigm; using pg8::q4_i8;
typedef float f32x16 __attribute__((ext_vector_type(16))); typedef float f32x32 __attribute__((ext_vector_type(32)));
typedef unsigned u32x6 __attribute__((ext_vector_type(6))); typedef int i32x8 __attribute__((ext_vector_type(8)));
__device__ __forceinline__ u32x6 pack_fp6(const f32x4 (&v)[8], float sc) {
    f32x16 a, b;
#pragma unroll
    for (int i = 0; i < 4; ++i)
#pragma unroll
        for (int e = 0; e < 2; ++e) {
            a[4 * i + e] = v[2 * i][2 * e] * sc; b[4 * i + e] = v[2 * i][2 * e + 1] * sc; a[4 * i + 2 + e] = v[2 * i + 1][2 * e] * sc; b[4 * i + 2 + e] = v[2 * i + 1][2 * e + 1] * sc; }
    return __builtin_amdgcn_cvt_scalef32_2xpk16_fp6_f32(a, b, 1.0f);
}
constexpr float PEER_SU = 80.f, PEER_SV = 1.75f;
constexpr float QW_2048 = 127.f / (6.5f * 0.02209708691f), QW_1024 = 127.f / (6.5f * 0.03125f);

namespace att {
constexpr int D = 128, NW = 8, QBLK = 32, KVBLK = 64;
constexpr float SCALE = 0.088388347648318440f;
constexpr float THR = 8.f;
constexpr int LDQ = 1024, LDK = 256, LDO = 1024;
constexpr size_t SHM_V = KVBLK * D * 2, SHM_K = KVBLK * D * 2, SHM_ATTN = 2 * SHM_V + 2 * SHM_K + NW * 64 * 4;
#define KSWZ(row, colB) ((row) * 256 + ((colB) ^ (((row) & 7) << 4)))
#define SBAR() __builtin_amdgcn_sched_barrier(0)
__device__ __forceinline__ int crow(int r, int hi) { return (r & 3) + 8 * (r >> 2) + 4 * hi; }
__device__ __forceinline__ unsigned cvtpk(float lo, float hi) { unsigned r; asm volatile("v_cvt_pk_bf16_f32 %0, %1, %2" : "=v"(r) : "v"(lo), "v"(hi)); return r; }
template <bool FIXED>
__device__ __forceinline__ void partialSM(f32x16& p0, f32x16& p1, float& m_reg, float& mn, float& alpha) {
  constexpr float C = SCALE * 1.4426950408889634f;
  if constexpr (FIXED) { mn = m_reg; alpha = 1.f; const float mnC_ = -m_reg * C;
    for (int r = 0; r < 16; ++r) p0[r] = fmaf(p0[r], C, mnC_); for (int r = 0; r < 16; ++r) p1[r] = fmaf(p1[r], C, mnC_);
    for (int r = 0; r < 16; ++r) p0[r] = __builtin_amdgcn_exp2f(p0[r]);
    return; }
  float pmax = p0[0]; for (int r = 1; r < 16; ++r) pmax = fmaxf(pmax, p0[r]); for (int r = 0; r < 16; ++r) pmax = fmaxf(pmax, p1[r]);
  { auto rr = __builtin_amdgcn_permlane32_swap(__float_as_uint(pmax), __float_as_uint(pmax), false, false);
    pmax = fmaxf(__uint_as_float(rr[0]), __uint_as_float(rr[1])); }
  if (__builtin_expect(__all(pmax - m_reg <= THR / SCALE), 1)) { mn = m_reg; alpha = 1.f; }
  else { mn = fmaxf(m_reg, pmax); alpha = __builtin_amdgcn_exp2f((m_reg - mn) * C); m_reg = mn; }
  float mnC = -mn * C;
  for (int r = 0; r < 16; ++r) p0[r] = fmaf(p0[r], C, mnC); for (int r = 0; r < 16; ++r) p1[r] = fmaf(p1[r], C, mnC);
  for (int r = 0; r < 16; ++r) p0[r] = __builtin_amdgcn_exp2f(p0[r]);
}
__device__ __forceinline__ void finishSM(f32x16& p0, f32x16& p1, float alpha, float& l_reg, bf16x8& pa0, bf16x8& pa1, bf16x8& pa2, bf16x8& pa3) {
  for (int r = 0; r < 16; ++r) p1[r] = __builtin_amdgcn_exp2f(p1[r]);
  float ps = 0; for (int r = 0; r < 16; ++r) ps += p0[r]; for (int r = 0; r < 16; ++r) ps += p1[r];
  { auto rr = __builtin_amdgcn_permlane32_swap(__float_as_uint(ps), __float_as_uint(ps), false, false);
    ps = __uint_as_float(rr[0]) + __uint_as_float(rr[1]); }
  l_reg = l_reg * alpha + ps;
#define PK4(P, BASE, OUT) do { unsigned a0 = cvtpk(P[BASE + 0], P[BASE + 1]), a1 = cvtpk(P[BASE + 2], P[BASE + 3]);   \
    unsigned b0 = cvtpk(P[BASE + 4], P[BASE + 5]), b1 = cvtpk(P[BASE + 6], P[BASE + 7]);                              \
    auto r0 = __builtin_amdgcn_permlane32_swap(a0, b0, false, false); auto r1 = __builtin_amdgcn_permlane32_swap(a1, b1, false, false); \
    u32x4 w = {r0[0], r1[0], r0[1], r1[1]}; OUT = *reinterpret_cast<bf16x8*>(&w); } while (0)
  PK4(p0, 0, pa0); PK4(p0, 8, pa1); PK4(p1, 0, pa2); PK4(p1, 8, pa3);
#undef PK4
}
__device__ __forceinline__ void qkt(f32x16& p0, f32x16& p1, const bf16_t* Ks, const bf16x8* qr, int r32, int hi) {
  p0 = f32x16{}; p1 = f32x16{};
  for (int d0 = 0; d0 < 8; ++d0) { int cb = (d0 * 16 + hi * 8) * 2;
    bf16x8 b0 = *reinterpret_cast<const bf16x8*>((const char*)Ks + KSWZ(r32, cb));
    bf16x8 b1 = *reinterpret_cast<const bf16x8*>((const char*)Ks + KSWZ(32 + r32, cb));
    p0 = __builtin_amdgcn_mfma_f32_32x32x16_bf16(b0, qr[d0], p0, 0, 0, 0);
    p1 = __builtin_amdgcn_mfma_f32_32x32x16_bf16(b1, qr[d0], p1, 0, 0, 0); }
}
__device__ __forceinline__ int v_st(int k, int c) { const int kk = (k & ~0xC) | ((k & 4) << 1) | ((k & 8) >> 1); return ((kk >> 3) * 4 + (c >> 5)) * 512 + ((kk & 7) * 32 + (c & 31)) * 2; }
__device__ __forceinline__ int v_rd_base(int lane) { return ((lane & 3) << 3) | (((lane >> 2) & 3) << 6) | (((lane >> 4) & 1) << 5) | (((lane >> 5) & 1) << 8); }
constexpr int v_rd_off(int d0, int ks, int half) { return d0 * 512 + ks * 4096 + half * 2048; }
template <int OFF> __device__ __forceinline__ s16x4 tr_read(int vb) {
  s16x4 r; asm volatile("ds_read_b64_tr_b16 %0, %1 offset:%2" : "=&v"(r) : "v"(vb), "i"(OFF) : "memory"); return r;
}
template <int D0> __device__ __forceinline__ void pv_one(f32x16& od, int vb, bf16x8 pa0, bf16x8 pa1, bf16x8 pa2, bf16x8 pa3) {
  const s16x4 l0 = tr_read<v_rd_off(D0, 0, 0)>(vb), h0 = tr_read<v_rd_off(D0, 0, 1)>(vb), l1 = tr_read<v_rd_off(D0, 1, 0)>(vb), h1 = tr_read<v_rd_off(D0, 1, 1)>(vb);
  const s16x4 l2 = tr_read<v_rd_off(D0, 2, 0)>(vb), h2 = tr_read<v_rd_off(D0, 2, 1)>(vb), l3 = tr_read<v_rd_off(D0, 3, 0)>(vb), h3 = tr_read<v_rd_off(D0, 3, 1)>(vb);
  asm volatile("s_waitcnt lgkmcnt(0)" ::: "memory"); SBAR();
#define PK(L, H) (bf16x8){L[0], L[1], L[2], L[3], H[0], H[1], H[2], H[3]}
  od = __builtin_amdgcn_mfma_f32_32x32x16_bf16(pa0, PK(l0, h0), od, 0, 0, 0);
  od = __builtin_amdgcn_mfma_f32_32x32x16_bf16(pa1, PK(l1, h1), od, 0, 0, 0);
  od = __builtin_amdgcn_mfma_f32_32x32x16_bf16(pa2, PK(l2, h2), od, 0, 0, 0);
  od = __builtin_amdgcn_mfma_f32_32x32x16_bf16(pa3, PK(l3, h3), od, 0, 0, 0);
#undef PK
}
__device__ __forceinline__ void pv_d0(f32x16* o, int vb, bf16x8 pa0, bf16x8 pa1, bf16x8 pa2, bf16x8 pa3) {
  pv_one<0>(o[0], vb, pa0, pa1, pa2, pa3); pv_one<1>(o[1], vb, pa0, pa1, pa2, pa3); pv_one<2>(o[2], vb, pa0, pa1, pa2, pa3); pv_one<3>(o[3], vb, pa0, pa1, pa2, pa3);
}
template <bool FIXED>
__device__ __forceinline__ void attn_dense_body(const bf16_t* __restrict__ Qb, const bf16_t* __restrict__ Kh, const bf16_t* __restrict__ Vh,
                                                bf16_t* __restrict__ Ob, int seq, char* lds, float mfix) {
  int tid_ = threadIdx.x; asm volatile("" : "+v"(tid_));
  const int tid = tid_, wid = __builtin_amdgcn_readfirstlane(tid >> 6), lane = tid & 63, r32 = lane & 31, hi = lane >> 5;
  bf16_t* V_lds = (bf16_t*)lds; bf16_t* K_lds = (bf16_t*)(lds + 2 * SHM_V);
  float* ws = (float*)(lds + 2 * SHM_V + 2 * SHM_K) + wid * 64; float* li_l = ws; float* al_l = ws + 32;
  float m_reg = FIXED ? mfix : -1e30f, l_reg = 0; f32x16 o[4] = {}; bf16x8 qr[8];
  const bf16_t* Qw = Qb + (long)(wid * QBLK + r32) * LDQ + hi * 8;
#pragma unroll
  for (int d0 = 0; d0 < 8; ++d0) qr[d0] = *reinterpret_cast<const bf16x8*>(Qw + d0 * 16);
  const int sr = tid >> 4, sc = (tid & 15) * 8, vst0 = v_st(sr, sc), vst1 = v_st(32 + sr, sc);
  const int vb0 = (int)(uintptr_t)V_lds + v_rd_base(lane);
  struct { bf16x8 vs0, vs1, ks0, ks1; } sr_[2];
#define SLOAD(i, k0) do { sr_[i].vs0 = *reinterpret_cast<const bf16x8*>(&Vh[(long)((k0) + sr) * LDK + sc]); sr_[i].vs1 = *reinterpret_cast<const bf16x8*>(&Vh[(long)((k0) + 32 + sr) * LDK + sc]); \
    sr_[i].ks0 = *reinterpret_cast<const bf16x8*>(&Kh[(long)((k0) + sr) * LDK + sc]); sr_[i].ks1 = *reinterpret_cast<const bf16x8*>(&Kh[(long)((k0) + 32 + sr) * LDK + sc]); } while (0)
#define SWRITE(b, i) do { *(bf16x8*)((char*)V_lds + (b) * SHM_V + vst0) = sr_[i].vs0;          \
    *(bf16x8*)((char*)V_lds + (b) * SHM_V + vst1) = sr_[i].vs1; int kc = sc * 2;               \
    *(bf16x8*)((char*)K_lds + (b) * SHM_K + KSWZ(sr, kc)) = sr_[i].ks0;                       \
    *(bf16x8*)((char*)K_lds + (b) * SHM_K + KSWZ(32 + sr, kc)) = sr_[i].ks1; } while (0)
#define SWAIT() asm volatile("s_waitcnt vmcnt(4)" ::: "memory")
#define RESC(a) do { if (!FIXED && __any((a) < 1.f)) { if (hi == 0) al_l[r32] = (a); asm volatile("s_waitcnt lgkmcnt(0)" ::: "memory"); \
    for (int d = 0; d < 4; ++d) for (int r = 0; r < 16; ++r) o[d][r] *= al_l[crow(r, hi)]; } } while (0)
  f32x16 pA0, pA1, pB0, pB1; float mnA, mnB, alA, alB; bf16x8 pa0, pa1, pa2, pa3; const int NT = seq / KVBLK;
  constexpr int SE = 0, SO = 1;
  SLOAD(SE, 0); asm volatile("s_waitcnt vmcnt(0)" ::: "memory"); SWRITE(0, SE); __syncthreads();
  qkt(pA0, pA1, K_lds, qr, r32, hi); partialSM<FIXED>(pA0, pA1, m_reg, mnA, alA);
  SLOAD(SO, KVBLK); if (2 < NT) SLOAD(SE, 2 * KVBLK);
  SWAIT(); SWRITE(1, SO); __syncthreads();
  for (int j = 1; j + 1 < NT; j += 2) {
    SBAR(); qkt(pB0, pB1, (bf16_t*)((char*)K_lds + SHM_K), qr, r32, hi);
    finishSM(pA0, pA1, alA, l_reg, pa0, pa1, pa2, pa3); SBAR();
    SLOAD(SO, (j + 2) * KVBLK); SBAR();
    pv_d0(o, vb0, pa0, pa1, pa2, pa3); partialSM<FIXED>(pB0, pB1, m_reg, mnB, alB);
    __syncthreads(); SWAIT(); SWRITE(0, SE);
    RESC(alB); __syncthreads();
    SBAR(); qkt(pA0, pA1, K_lds, qr, r32, hi);
    finishSM(pB0, pB1, alB, l_reg, pa0, pa1, pa2, pa3); SBAR();
    if (j + 3 < NT) SLOAD(SE, (j + 3) * KVBLK); SBAR();
    pv_d0(o, vb0 + (int)SHM_V, pa0, pa1, pa2, pa3); partialSM<FIXED>(pA0, pA1, m_reg, mnA, alA);
    __syncthreads(); SWAIT(); SWRITE(1, SO);
    RESC(alA); __syncthreads();
  }
  SBAR(); qkt(pB0, pB1, (bf16_t*)((char*)K_lds + SHM_K), qr, r32, hi);
  finishSM(pA0, pA1, alA, l_reg, pa0, pa1, pa2, pa3); SBAR();
  pv_d0(o, vb0, pa0, pa1, pa2, pa3); partialSM<FIXED>(pB0, pB1, m_reg, mnB, alB);
  __syncthreads(); RESC(alB);
  finishSM(pB0, pB1, alB, l_reg, pa0, pa1, pa2, pa3); SBAR();
  pv_d0(o, vb0 + (int)SHM_V, pa0, pa1, pa2, pa3);
  if (hi == 0) li_l[r32] = l_reg; asm volatile("s_waitcnt lgkmcnt(0)" ::: "memory");
  float rli[16];
#pragma unroll
  for (int r = 0; r < 16; ++r) rli[r] = __builtin_amdgcn_rcpf(li_l[crow(r, hi)]);
  bf16_t* Ow = Ob + (long)(wid * QBLK) * LDO;
#pragma unroll
  for (int r = 0; r < 16; ++r) { int orow = crow(r, hi);
    for (int d0 = 0; d0 < 4; ++d0) Ow[(long)orow * LDO + d0 * 32 + r32] = (bf16_t)(cvtpk(o[d0][r] * rli[r], 0.f) & 0xffffu); }
  __syncthreads();
#undef SLOAD
#undef SWRITE
#undef SWAIT
#undef RESC
}
#undef KSWZ
#undef SBAR
}

constexpr size_t MiB = 1u << 20;
constexpr size_t WS_CTL = 0, CTL_ZERO_BYTES = 1 * MiB;
constexpr size_t WS_WIN = 1 * MiB, WS_WAB = 55 * MiB, WS_WRB = 51 * MiB, WS_WMO = 59 * MiB, WS_WPQ = 67 * MiB, WS_KBD = 75 * MiB, WS_ROPE = 76 * MiB;
constexpr size_t WS_NWP = 78 * MiB;
constexpr size_t WS_HN = 80 * MiB;
constexpr size_t WS_QA = 148 * MiB, WS_KA = 180 * MiB, WS_VA = WS_KA + 8704 * 1024, WS_QR = 197 * MiB, WS_KR = 229 * MiB, WS_VR = 263 * MiB;
constexpr size_t WS_GR = 331 * MiB, WS_GA = 395 * MiB, WS_GT = 459 * MiB, WS_OATT = 523 * MiB, WS_OF = 555 * MiB, WS_OB = WS_HN;
constexpr size_t WS_RET = 148 * MiB, WS_T = 263 * MiB  , WS_MIX = WS_HN  , WS_X1 = 508 * MiB, WS_U = 1 * MiB, WS_V = 25 * MiB  , WS_H2 = WS_HN, WS_PQ = 188 * MiB, WS_SCT = 380 * MiB, WS_OATT8 = 212 * MiB  ;
constexpr size_t WS_RS = 79 * MiB;
constexpr size_t WS_W2 = 619 * MiB, WS_W2Q = 627 * MiB  , WS_MIXQ = 80 * MiB  , WS_H2Q = 148 * MiB  ;
constexpr size_t WS_END = 636 * MiB;
static_assert(WS_VA + (size_t)MT * 256 * 2 <= WS_QR && WS_KA + (size_t)MT * 256 * 2 <= WS_VA, "ws map");
constexpr int CW_BAR = 4096;
constexpr int CW_MOD = 131072;
constexpr int CW_DBG = 8192;

constexpr int RING_BYTES = 131072, LDS_BYTES = 147456, MISC_OFF = LDS_BYTES - 256;

#define XB_TMO      128
#define XB_XCNT(j)  (256  + 64 * (j))
#define XB_XSUB(j)  (1280 + 64 * (j))
#define XB_XGEN(j)  (2304 + 64 * (j))
#define XB_TOP      3328
#define XB_TOPGEN   3392
#define XCD_BAR_WORDS 3456
#define XB_SPIN_CAP (1u << 18)
__device__ __forceinline__ unsigned xb_ld(unsigned* p)              { return __hip_atomic_load(p, __ATOMIC_RELAXED, __HIP_MEMORY_SCOPE_AGENT); }
__device__ __forceinline__ unsigned xb_add(unsigned* p, unsigned v) { return __hip_atomic_fetch_add(p, v, __ATOMIC_RELAXED, __HIP_MEMORY_SCOPE_AGENT); }
__device__ __forceinline__ unsigned xb_xcc_id() { return (unsigned)__builtin_amdgcn_s_getreg((3 << 11) | 20) & 0xFu; }
#define XB_SPIN(cond, bar) do { unsigned _sp = 0; while (cond) { __builtin_amdgcn_s_sleep(1); \
    if ((++_sp & 255u) == 0u) { if (xb_ld(&(bar)[XB_TMO])) break; if (_sp > XB_SPIN_CAP) { atomicAdd(&(bar)[XB_TMO], 1u); break; } } } } while (0)
struct XcdBarrier { unsigned* bar; unsigned x; volatile LAS unsigned* st; };
__device__ __forceinline__ XcdBarrier xcd_barrier_post(unsigned* bar, volatile LAS unsigned* st) {
    XcdBarrier b; b.bar = bar; b.x = xb_xcc_id(); b.st = st;
    if (threadIdx.x == 0) (void)xb_add(&bar[XB_XCNT(b.x)], 1u);
    return b;
}
__device__ __forceinline__ void xcd_barrier_complete(unsigned* bar, unsigned x, unsigned& nloc, unsigned& nx) {
    const unsigned G = gridDim.x * gridDim.y * gridDim.z;
    unsigned sum, cnt, mine, sp = 0u;
    for (;;) {
        sum = 0u; cnt = 0u; mine = 0u;
#pragma unroll
        for (unsigned j = 0; j < 16; ++j) { const unsigned c = xb_ld(&bar[XB_XCNT(j)]); sum += c; cnt += (c > 0u) ? 1u : 0u; mine = (j == x) ? c : mine; }
        if (sum == G) break;
        __builtin_amdgcn_s_sleep(1);
        if ((++sp & 255u) == 0u) { if (xb_ld(&bar[XB_TMO])) break; if (sp > XB_SPIN_CAP) { atomicAdd(&bar[XB_TMO], 1u); break; } }
    }
    nloc = mine > 0u ? mine : 1u; nx = cnt > 0u ? cnt : 1u;
}
__device__ __forceinline__ void xcd_barrier(const XcdBarrier& b) {
    asm volatile("s_waitcnt vmcnt(0)" ::: "memory");
    __syncthreads();
    if (threadIdx.x == 0) {
        unsigned* bar = b.bar;
        __builtin_amdgcn_s_waitcnt(0);
        unsigned nloc = b.st[0], nx = b.st[1];
        if (nloc == 0u) { xcd_barrier_complete(bar, b.x, nloc, nx); b.st[0] = nloc; b.st[1] = nx; }
        const unsigned old = xb_add(&bar[XB_XSUB(b.x)], 1u);
        const unsigned gen = old / nloc;
        if (old + 1u == (gen + 1u) * nloc) {
            __builtin_amdgcn_fence(__ATOMIC_RELEASE, "agent");
            asm volatile("s_waitcnt vmcnt(0)" ::: "memory");
            const unsigned og = xb_add(&bar[XB_TOP], 1u);
            const unsigned tg = og / nx;
            if (og + 1u == (tg + 1u) * nx) xb_add(&bar[XB_TOPGEN], 1u);
            else XB_SPIN(xb_ld(&bar[XB_TOPGEN]) == tg, bar);
            __builtin_amdgcn_fence(__ATOMIC_ACQUIRE, "agent");
            xb_add(&bar[XB_XGEN(b.x)], 1u);
            asm volatile("s_waitcnt vmcnt(0)" ::: "memory");
        } else {
            XB_SPIN(xb_ld(&bar[XB_XGEN(b.x)]) == gen, bar);
            __builtin_amdgcn_fence(__ATOMIC_ACQUIRE, "agent");
            asm volatile("s_waitcnt vmcnt(0)" ::: "memory");
        }
    }
    __syncthreads();
}

__device__ __forceinline__ float wave_sum(float v) {
#pragma unroll
    for (int o = 1; o < 64; o <<= 1) v += __shfl_xor(v, o);
    return v;
}
__device__ __forceinline__ float wave_max(float v) {
#pragma unroll
    for (int o = 1; o < 64; o <<= 1) v = fmaxf(v, __shfl_xor(v, o));
    return v;
}
__device__ __forceinline__ float half_sum(float v) {
#pragma unroll
    for (int o = 1; o < 32; o <<= 1) v += __shfl_xor(v, o);
    return v;
}
__device__ __forceinline__ float dpp_row_shr(float v, int n) {
    const int iv = __builtin_bit_cast(int, v); int r;
    switch (n) { case 1: r = __builtin_amdgcn_update_dpp(0, iv, 0x111, 0xf, 0xf, true); break; case 2: r = __builtin_amdgcn_update_dpp(0, iv, 0x112, 0xf, 0xf, true); break;
                 case 4: r = __builtin_amdgcn_update_dpp(0, iv, 0x114, 0xf, 0xf, true); break; default: r = __builtin_amdgcn_update_dpp(0, iv, 0x118, 0xf, 0xf, true); break; }
    return __builtin_bit_cast(float, r);
}
__device__ __forceinline__ float wave_sum_l63(float v) {
    v += dpp_row_shr(v, 1); v += dpp_row_shr(v, 2); v += dpp_row_shr(v, 4); v += dpp_row_shr(v, 8);
    v += __builtin_bit_cast(float, __builtin_amdgcn_update_dpp(0, __builtin_bit_cast(int, v), 0x142, 0xa, 0xf, false));
    v += __builtin_bit_cast(float, __builtin_amdgcn_update_dpp(0, __builtin_bit_cast(int, v), 0x143, 0xc, 0xf, false));
    return v;
}
__device__ __forceinline__ float wave_allsum(float v) {
    return __uint_as_float(__builtin_amdgcn_readlane(__float_as_uint(wave_sum_l63(v)), 63));
}
__device__ __forceinline__ unsigned f2bf(float f) { unsigned u = __builtin_bit_cast(unsigned, f); return (u + 0x7fffu + ((u >> 16) & 1u)) >> 16; }
__device__ __forceinline__ unsigned pk2(float lo, float hi) { return f2bf(lo) | (f2bf(hi) << 16); }
__device__ __forceinline__ float dot2_bf16(unsigned w, unsigned x, float acc) { return __builtin_amdgcn_fdot2_f32_bf16(__builtin_bit_cast(bf16x2_t, w), __builtin_bit_cast(bf16x2_t, x), acc, false); }

struct Args { const float* in[22]; float* out; unsigned char* ws; int ph_lo, ph_hi, pass, pad; };

__device__ __forceinline__ int win_perm(int col) { const bool seg = col < 1280 || (col >= 1536 && col < 3584); if (!seg) return col; const int c = col & 127; return (col & ~127) + 2 * (c & 63) + (c >> 6); }
template <bool PERMROWS, bool I8OUT>
__device__ __forceinline__ void p0_transpose_item(const float* W, int K, int N, bf16_t* WT, LAS float* scr, int item, int lane, float qs = 1.f) {
    const int nblk = N / 64, kb = item / nblk, nb = item % nblk, k0 = 64 * kb, n0 = 64 * nb;
    const int n4 = lane & 15, rg = lane >> 4;
    f32x4 t[16];
#pragma unroll
    for (int i = 0; i < 16; ++i) t[i] = *(const f32x4*)(W + (size_t)(k0 + 4 * i + rg) * N + n0 + 4 * n4);
#pragma unroll
    for (int i = 0; i < 16; ++i) *(LAS f32x4*)(scr + (4 * i + rg) * 68 + 4 * n4) = t[i];
    asm volatile("s_waitcnt lgkmcnt(0)" ::: "memory");
    const LAS float* sc = scr + lane;
    const size_t orow = (size_t)(PERMROWS ? win_perm(n0 + lane) : n0 + lane) * K + k0;
    if constexpr (I8OUT) {
#pragma unroll
        for (int q = 0; q < 4; ++q) { u32x4 o;
#pragma unroll
            for (int e = 0; e < 4; ++e) { const LAS float* s4 = sc + (16 * q + 4 * e) * 68; o[e] = q4_i8((f32x4){s4[0], s4[68], s4[136], s4[204]} * qs); }
            *(u32x4*)((unsigned char*)WT + orow + 16 * q) = o; }
    } else {
#pragma unroll
        for (int q = 0; q < 8; ++q) { const LAS float* s8 = sc + (8 * q) * 68;
            u32x4 o; o.x = pk2(s8[0], s8[68]); o.y = pk2(s8[2 * 68], s8[3 * 68]); o.z = pk2(s8[4 * 68], s8[5 * 68]); o.w = pk2(s8[6 * 68], s8[7 * 68]);
            *(u32x4*)(WT + orow + 8 * q) = o; }
    }
    asm volatile("s_waitcnt lgkmcnt(0)" ::: "memory");
}
__device__ __forceinline__ void p0_convert_item(const float* W, bf16_t* O, int item, int lane) {
    f32x4 a[8], b[8];
#pragma unroll
    for (int i = 0; i < 8; ++i) { const size_t e = (size_t)item * 4096 + (size_t)(i * 64 + lane) * 8; a[i] = *(const f32x4*)(W + e); b[i] = *(const f32x4*)(W + e + 4); }
#pragma unroll
    for (int i = 0; i < 8; ++i) { const size_t e = (size_t)item * 4096 + (size_t)(i * 64 + lane) * 8; *(u32x4*)(O + e) = pg8::pack8(a[i], b[i]); }
}
__device__ __forceinline__ void phase0(const Args& A, LAS unsigned char* lds, int G, int tid, int lane, int wave) {
    unsigned char* ws = A.ws;
    const int gw = blockIdx.x * 8 + wave, NGW = G * 8;
    float* modacc = (float*)(ws + WS_CTL) + CW_MOD;
    {
        const float* cvec = A.in[1]; const float* cctx = A.in[3]; const float* aw = A.in[4]; const float* ab = A.in[5];
        LAS float* sil = (LAS float*)lds;
        LAS float* red = (LAS float*)(lds + 40960);
        if (blockIdx.x < 192) {
            int t1 = threadIdx.x; asm volatile("" : "+v"(t1));
            for (int e = t1; e < 5 * 2048; e += 512) { const int r = e >> 11, k = e & 2047; const float cvv = r < 4 ? cvec[r * 2048 + k] : cctx[k]; sil[e] = cvv * sigm(cvv); }
            __syncthreads();
        }
        for (int it = blockIdx.x; it < 192; it += G) {
            const int n4 = lane & 15, rg = lane >> 4, n = it * 64 + 4 * n4;
            f32x4 acc[5];
#pragma unroll
            for (int r = 0; r < 5; ++r) acc[r] = (f32x4){0.f, 0.f, 0.f, 0.f};
#pragma unroll 1
            for (int ib = 0; ib < 4; ++ib) { f32x4 wv[16];
#pragma unroll
                for (int i = 0; i < 16; ++i) wv[i] = *(const f32x4*)(aw + (size_t)(wave * 256 + ib * 64 + 4 * i + rg) * 12288 + n);
#pragma unroll
                for (int i = 0; i < 16; ++i) { const int k = wave * 256 + ib * 64 + 4 * i + rg;
#pragma unroll
                    for (int r = 0; r < 5; ++r) acc[r] += wv[i] * sil[r * 2048 + k]; } }
#pragma unroll
            for (int r = 0; r < 5; ++r)
#pragma unroll
                for (int e = 0; e < 4; ++e) { float v = acc[r][e]; v += __shfl_xor(v, 16); v += __shfl_xor(v, 32); acc[r][e] = v; }
            __syncthreads();
            if (rg == 0) {
#pragma unroll
                for (int r = 0; r < 5; ++r) *(LAS f32x4*)(red + (wave * 5 + r) * 64 + 4 * n4) = acc[r]; }
            __syncthreads();
            int t2 = threadIdx.x; asm volatile("" : "+v"(t2));
            if (t2 < 320) { const int r = t2 >> 6, cidx = t2 & 63; float sum = ab[it * 64 + cidx];
#pragma unroll
                for (int w8 = 0; w8 < 8; ++w8) sum += red[(w8 * 5 + r) * 64 + cidx];
                modacc[r * 12288 + it * 64 + cidx] = sum; }
        }
        __syncthreads();
    }
    {
        LAS float* scr = (LAS float*)(lds + wave * 17408);
        constexpr int I0 = 32 * 184, I1 = 16 * 32, I2 = 32 * 32, I3 = 32 * 32, I4 = 1024, NIT = I0 + I1 + I2 + I3 + I4;
#define P0_ITEM(IT) do { int r = (IT); \
            if (r < I0) p0_transpose_item<true, true>(A.in[7], 2048, INW, (bf16_t*)(ws + WS_WIN), scr, r, lane, QW_2048); \
            else if ((r -= I0) < I1) p0_transpose_item<false, true>(A.in[13], 1024, 2048, (bf16_t*)(ws + WS_WAB), scr, r, lane, QW_1024); \
            else if ((r -= I1) < I2) p0_transpose_item<false, true>(A.in[14], 2048, 2048, (bf16_t*)(ws + WS_WRB), scr, r, lane, QW_2048); \
            else if ((r -= I2) < I3) p0_transpose_item<false, true>(A.in[15], 2048, 2048, (bf16_t*)(ws + WS_WMO), scr, r, lane, QW_2048); \
            else p0_convert_item(A.in[17], (bf16_t*)(ws + WS_WPQ), (r - I3), lane); } while (0)
        if (G == 256) { constexpr int NA = 2048;
            if (blockIdx.x >= 192) for (int it = ((int)blockIdx.x - 192) * 8 + wave; it < NA; it += 64 * 8) P0_ITEM(it);
            for (int it = NA + gw; it < NIT; it += NGW) P0_ITEM(it);
        } else for (int it = gw; it < NIT; it += NGW) P0_ITEM(it);
#undef P0_ITEM
    }
    {
        const int gt = blockIdx.x * 512 + tid, NT = G * 512;
        f32x2* cs = (f32x2*)(ws + WS_ROPE);
        for (int e = gt; e < SEQ * 64; e += NT) { const int t = e >> 6, i = e & 63;
            const float inv = exp2f(-(float)(i & 31) * (13.287712379549449f / 32.0f)); const float pos = (float)(i < 32 ? (t >> 6) : (t & 63)); const float ang = pos * inv;
            cs[e] = (f32x2){cosf(ang), sinf(ang)}; }
        if (gt < 256) { float* nwp = (float*)(ws + WS_NWP); const int pp = gt & 127; nwp[gt] = (gt < 128 ? A.in[8] : A.in[9])[(pp >> 1) + 64 * (pp & 1)]; }
        bf16_t* kbd = (bf16_t*)(ws + WS_KBD); const float* keys = A.in[18];
        for (int e = gt; e < 8 * 256 * 256; e += NT) { const int j = e >> 16, r = (e >> 8) & 255, k = e & 255, p = r >> 7, n = r & 127;
            const float v = ((k >> 7) == p) ? keys[((size_t)((j * 2 + p) * 128 + n)) * 128 + (k & 127)] : 0.f; kbd[e] = (bf16_t)f2bf(v); }
    }
}

template <int OUT, bool BFIN = false>
__device__ __forceinline__ void norm_mod_row(const float* xr, const float* w, const float* shift, const float* scale, bf16_t* orow, int lane, float* rsout = nullptr, unsigned char* orow8 = nullptr) {
    f32x4 v[8]; float s = 0.f;
#pragma unroll
    for (int j = 0; j < 8; ++j) {
        if constexpr (BFIN) { const u32x2 q = *(const u32x2*)((const bf16_t*)xr + 4 * lane + 256 * j); v[j] = (f32x4){bf_lo(q.x), bf_hi(q.x), bf_lo(q.y), bf_hi(q.y)}; }
        else v[j] = *(const f32x4*)(xr + 4 * lane + 256 * j);
        s += (v[j].x * v[j].x + v[j].y * v[j].y) + (v[j].z * v[j].z + v[j].w * v[j].w); }
    const float rstd = rsqrtf(wave_allsum(s) * (1.f / 2048.f) + EPS);
    float am = 0.f;
#pragma unroll
    for (int j = 0; j < 8; ++j) { const int c = 4 * lane + 256 * j; const f32x4 wv = *(const f32x4*)(w + c), sh = *(const f32x4*)(shift + c), sc = *(const f32x4*)(scale + c);
        v[j] = (v[j] * rstd * wv) * (sc + 1.0f) + sh;
        if constexpr (OUT != 0) am = fmaxf(fmaxf(am, fmaxf(fabsf(v[j].x), fabsf(v[j].y))), fmaxf(fabsf(v[j].z), fabsf(v[j].w)));
        if constexpr (OUT != 1) { u32x2 pk; pk.x = cvt_pk_bf16(v[j].x, v[j].y); pk.y = cvt_pk_bf16(v[j].z, v[j].w); *(u32x2*)(orow + c) = pk; } }
    if constexpr (OUT != 0) {
        am = fmaxf(wave_max(am), 1e-20f); const float qs = 127.f / am; if (lane == 0) *rsout = am * (1.f / 127.f);
        unsigned char* o8 = OUT == 1 ? (unsigned char*)orow : orow8;
#pragma unroll
        for (int j = 0; j < 8; ++j) *(unsigned*)(o8 + 4 * lane + 256 * j) = q4_i8(v[j] * qs); }
}
__device__ __forceinline__ void phase1(const Args& A, int G, int lane, int wave) {
    const int gw = blockIdx.x * 8 + wave, NGW = G * 8;
    const float* modacc = (const float*)(A.ws + WS_CTL) + CW_MOD; bf16_t* HN = (bf16_t*)(A.ws + WS_HN);
#define P1_ROW(R_) do { const int R = (R_); const int b = R / LT, j = R % LT; \
        const float* src = j < LC ? A.in[2] + (size_t)(b * LC + j) * DM : A.in[0] + (size_t)(b * SEQ + j - LC) * DM; \
        const float* md = modacc + (j < LC ? 4 : b) * 12288; \
        norm_mod_row<1>(src, A.in[6], md, md + 2048, (bf16_t*)((unsigned char*)HN + (size_t)R * DM), lane, (float*)(A.ws + WS_RS) + R); } while (0)
    if (G == 256) {
        for (int k = 0; k < 7; ++k) P1_ROW(gw + k * 2048);
        if (blockIdx.x >= 64) for (int rr = 7 * 2048 + (gw - 512); rr < MT; rr += 1536) P1_ROW(rr);
    } else for (int rr = gw; rr < MT; rr += NGW) P1_ROW(rr);
#undef P1_ROW
}

__device__ __forceinline__ void head_fix(bf16_t* hp, const float* nw, const f32x2* cs, float scale, int lp) {
    unsigned* p0 = (unsigned*)(hp + 2 * lp); unsigned* p1 = (unsigned*)(hp + 64 + 2 * lp);
    const unsigned u0 = *p0, u1 = *p1;
    float x1a = bf_lo(u0), x1b = bf_hi(u0), x2a = bf_lo(u1), x2b = bf_hi(u1);
    if (nw) { const float ss = half_sum((x1a * x1a + x1b * x1b) + (x2a * x2a + x2b * x2b)); const float r = rsqrtf(ss * (1.f / 128.f) + EPS);
        x1a *= r * nw[2 * lp]; x1b *= r * nw[2 * lp + 1]; x2a *= r * nw[64 + 2 * lp]; x2b *= r * nw[64 + 2 * lp + 1]; }
    if (cs) { const f32x2 ca = cs[2 * lp], cb = cs[2 * lp + 1];
        const float o1a = x1a * ca.x - x2a * ca.y, o2a = x2a * ca.x + x1a * ca.y, o1b = x1b * cb.x - x2b * cb.y, o2b = x2b * cb.x + x1b * cb.y;
        x1a = o1a; x2a = o2a; x1b = o1b; x2b = o2b; }
    *p0 = cvt_pk_bf16(x1a * scale, x1b * scale); *p1 = cvt_pk_bf16(x2a * scale, x2b * scale);
}
__device__ __forceinline__ void phase3(const Args& A, int G, int lane, int wave) {
    const int gw = blockIdx.x * 8 + wave, NGW = G * 8, lp = lane & 31, hi = lane >> 5;
    unsigned char* ws = A.ws;
    bf16_t *QA = (bf16_t*)(ws + WS_QA), *KA = (bf16_t*)(ws + WS_KA), *QR = (bf16_t*)(ws + WS_QR), *KR = (bf16_t*)(ws + WS_KR);
    const f32x2* cs = (const f32x2*)(ws + WS_ROPE); const float* qnw = A.in[8]; const float* knw = A.in[9];
    for (int R = gw; R < MT; R += NGW) { const int b = R / LT, j = R % LT;
        if (j < LC) { head_fix(KA + (size_t)R * 256 + hi * 128, knw, nullptr, 1.f, lp); continue; }
        const int t = j - LC; const size_t lr = (size_t)b * SEQ + t; const f32x2* ct = cs + (size_t)t * 64;
#pragma unroll
        for (int it = 0; it < 4; ++it) head_fix(QA + lr * 1024 + (2 * it + hi) * 128, qnw, ct, 1.f, lp);
        head_fix(KA + (size_t)R * 256 + hi * 128, knw, ct, 1.f, lp);
#pragma unroll
        for (int it = 0; it < 4; ++it) head_fix(QR + lr * 1024 + (2 * it + hi) * 128, nullptr, ct, 0.088388347648318440f, lp);
#pragma unroll
        for (int it = 0; it < 4; ++it) head_fix(KR + (size_t)R * 1024 + (2 * it + hi) * 128, nullptr, ct, 1.f, lp);
    }
}

namespace ret {
__device__ __forceinline__ unsigned off_b(unsigned row, unsigned ch) { return 256u * row + 16u * (ch ^ (((row & 3) << 2) | ((row >> 2) & 3))); }
__device__ __forceinline__ unsigned rra16(unsigned lane, unsigned rb, unsigned s) { return off_b((lane & 15) + 16 * rb, 4 * s + (lane >> 4)); }
__device__ __forceinline__ unsigned tra16(unsigned lane, unsigned c, unsigned ks, unsigned t) { const unsigned g = lane >> 4, q = (lane & 15) >> 2, p = lane & 3; return off_b(32 * ks + 8 * g + 4 * t + q, 2 * c + (p >> 1)) + 8 * (p & 1); }
typedef short v4i16 __attribute__((ext_vector_type(4)));
__device__ __forceinline__ bf16x8 rowfrag(LAS unsigned char* tile, unsigned lane, unsigned rb, unsigned s) { return *(LAS bf16x8*)(tile + rra16(lane, rb, s)); }
__device__ __forceinline__ bf16x8 trfrag(LAS unsigned char* tile, unsigned lane, unsigned c, unsigned ks) {
    const v4i16 lo = __builtin_amdgcn_ds_read_tr16_b64_v4i16((LAS v4i16*)(tile + tra16(lane, c, ks, 0)));
    const v4i16 hi = __builtin_amdgcn_ds_read_tr16_b64_v4i16((LAS v4i16*)(tile + tra16(lane, c, ks, 1)));
    return (bf16x8){lo[0], lo[1], lo[2], lo[3], hi[0], hi[1], hi[2], hi[3]};
}
__device__ __forceinline__ void unit(LAS unsigned char* L, int b, int h, int dir, int dvq, const bf16_t* QR, const bf16_t* KR, const bf16_t* VR, bf16_t* Oout, float z, unsigned* dbg,
                                     const float* tabU, const float* tabV, unsigned char* t6u, unsigned char* t6v) {
    unsigned ck0 = 0u, ck1 = 0u, ck2 = 0u, ck3 = 0u;
#define CK(acc, v) acc += (v) * 2654435761u + ((v) >> 7)
    int tid_ = threadIdx.x; asm volatile("" : "+v"(tid_), "+v"(z));
    const int tid = tid_, lane = tid & 63, w = __builtin_amdgcn_readfirstlane(tid >> 6);
    LAS unsigned char *Qs = L, *Ks = L + 32768, *Vs = L + 65536, *STs = L + 98304;
    const float lg2 = -__expf(z) * 1.4426950408889634f;
    const float cd = exp2f(lg2 * 128.f);
    const int c16 = tid & 15, r16 = tid >> 4, c8 = tid & 7, r8 = tid >> 3;
    float kdv[2];
#pragma unroll
    for (int i = 0; i < 2; ++i) { const int row = r8 + 64 * i; kdv[i] = dir == 0 ? exp2f(lg2 * (float)(127 - row)) : exp2f(lg2 * (float)row); }
    const int wm = w & 3, wn = w >> 2, l15 = lane & 15, lq = lane >> 4;
    float qd[2], rs[2];
#pragma unroll
    for (int tf = 0; tf < 2; ++tf) { const int tl = wm * 32 + tf * 16 + l15;
        qd[tf] = dir == 0 ? exp2f(lg2 * (float)(tl + 1)) : exp2f(lg2 * (float)(128 - tl));
        rs[tf] = dir == 0 ? exp2f(lg2 * (float)(tl - 127)) : exp2f(-lg2 * (float)tl); }
    f32x4 accST[2][2];
#pragma unroll
    for (int a = 0; a < 2; ++a)
#pragma unroll
        for (int c = 0; c < 2; ++c) accST[a][c] = (f32x4){0.f, 0.f, 0.f, 0.f};
    __syncthreads();
    { u32x4 zz = {0u, 0u, 0u, 0u}; for (int q = tid; q < 114688 / 16; q += 512) *(LAS u32x4*)(L + q * 16) = zz; }
    const int kb = w & 3, db = w >> 2;
    u32x4 pq[4], pk[4], pv[2];
#define RET_CC(st) (dir == 0 ? (st) : ((st) == 0 ? 1 : ((st) == 1 ? 0 : 35 - (st))))
#define RET_LOAD(st) do { const int cc_ = RET_CC(st); const size_t R0_ = (size_t)b * LT + (size_t)cc_ * 128, lr0_ = (size_t)b * SEQ + (size_t)(cc_ - 2) * 128; \
        if ((st) >= 2) { _Pragma("unroll") for (int i = 0; i < 4; ++i) pq[i] = *(const u32x4*)(QR + (lr0_ + r16 + 32 * i) * 1024 + h * 128 + c16 * 8); } \
        _Pragma("unroll") for (int i = 0; i < 4; ++i) pk[i] = *(const u32x4*)(KR + (R0_ + r16 + 32 * i) * 1024 + h * 128 + c16 * 8); \
        _Pragma("unroll") for (int i = 0; i < 2; ++i) pv[i] = *(const u32x4*)(VR + (R0_ + r8 + 64 * i) * 2048 + h * 256 + dvq * 64 + c8 * 8); } while (0)
    RET_LOAD(0);
    for (int step = 0; step < 34; ++step) {
        const int cc = RET_CC(step);
        const bool latent = step >= 2;
        const size_t lr0 = (size_t)b * SEQ + (size_t)(cc - 2) * 128;
        __syncthreads();
        if (latent) {
#pragma unroll
            for (int i = 0; i < 4; ++i) *(LAS u32x4*)(Qs + off_b(r16 + 32 * i, c16)) = pq[i];
        }
#pragma unroll
        for (int i = 0; i < 4; ++i) *(LAS u32x4*)(Ks + off_b(r16 + 32 * i, c16)) = pk[i];
#pragma unroll
        for (int i = 0; i < 2; ++i) { const int row = r8 + 64 * i; const u32x4 v = pv[i]; const float kd = kdv[i];
            u32x4 o; o.x = cvt_pk_bf16(bf_lo(v.x) * kd, bf_hi(v.x) * kd); o.y = cvt_pk_bf16(bf_lo(v.y) * kd, bf_hi(v.y) * kd); o.z = cvt_pk_bf16(bf_lo(v.z) * kd, bf_hi(v.z) * kd); o.w = cvt_pk_bf16(bf_lo(v.w) * kd, bf_hi(v.w) * kd);
            *(LAS u32x4*)(Vs + off_b(row, c8)) = o; }
        const bool tjob = (step & 1) == 0 && step < 32; const int tjb = step >> 1; f32x4 tv[8];
        const size_t trow = (size_t)((tjb & 7) * 2048 + (int)blockIdx.x * 8 + w);
        if (tjob) { const float* tsrc = (tjb < 8 ? tabU : tabV) + trow * 2048 + 4 * lane;
#pragma unroll
            for (int i = 0; i < 8; ++i) tv[i] = *(const f32x4*)(tsrc + 256 * i); }
        __syncthreads();
        f32x4 accS[4][2], accC[2][2];
#pragma unroll
        for (int a = 0; a < 4; ++a)
#pragma unroll
            for (int c = 0; c < 2; ++c) accS[a][c] = (f32x4){0.f, 0.f, 0.f, 0.f};
#pragma unroll
        for (int a = 0; a < 2; ++a)
#pragma unroll
            for (int c = 0; c < 2; ++c) accC[a][c] = (f32x4){0.f, 0.f, 0.f, 0.f};
        if (latent) {
            bf16x8 qf[2][4];
#pragma unroll
            for (int tf = 0; tf < 2; ++tf)
#pragma unroll
                for (int ks = 0; ks < 4; ++ks) qf[tf][ks] = rowfrag(Qs, lane, wm * 2 + tf, ks);
#pragma unroll
            for (int tq = 0; tq < 4; ++tq)
#pragma unroll
                for (int ks = 0; ks < 4; ++ks) { const bf16x8 kf = rowfrag(Ks, lane, wn * 4 + tq, ks);
#pragma unroll
                    for (int tf = 0; tf < 2; ++tf) accS[tq][tf] = __builtin_amdgcn_mfma_f32_16x16x32_bf16(kf, qf[tf][ks], accS[tq][tf], 0, 0, 0); }
#pragma unroll
            for (int dq = 0; dq < 2; ++dq)
#pragma unroll
                for (int ks = 0; ks < 4; ++ks) { const bf16x8 sf = rowfrag(STs, lane, wn * 2 + dq, ks);
#pragma unroll
                    for (int tf = 0; tf < 2; ++tf) accC[dq][tf] = __builtin_amdgcn_mfma_f32_16x16x32_bf16(sf, qf[tf][ks], accC[dq][tf], 0, 0, 0); }
#pragma unroll
            for (int dq = 0; dq < 2; ++dq)
#pragma unroll
                for (int tf = 0; tf < 2; ++tf) accC[dq][tf] *= qd[tf];
#pragma unroll
            for (int tq = 0; tq < 4; ++tq)
#pragma unroll
                for (int tf = 0; tf < 2; ++tf) { const int t = wm * 32 + tf * 16 + l15, tp0 = 16 * (wn * 4 + tq) + 4 * lq;
#pragma unroll
                    for (int e = 0; e < 4; ++e) { const int tp = tp0 + e; const bool keep = dir == 0 ? (tp <= t) : (tp >= t); accS[tq][tf][e] = keep ? accS[tq][tf][e] * rs[tf] : 0.f; } }
        }
#pragma unroll
        for (int kq = 0; kq < 2; ++kq)
#pragma unroll
            for (int dq = 0; dq < 2; ++dq) accST[kq][dq] *= cd;
#pragma unroll
        for (int ks = 0; ks < 4; ++ks) { bf16x8 kfr[2], vfr[2];
#pragma unroll
            for (int q = 0; q < 2; ++q) { kfr[q] = trfrag(Ks, lane, kb * 2 + q, ks); vfr[q] = trfrag(Vs, lane, db * 2 + q, ks); }
#pragma unroll
            for (int kq = 0; kq < 2; ++kq)
#pragma unroll
                for (int dq = 0; dq < 2; ++dq) accST[kq][dq] = __builtin_amdgcn_mfma_f32_16x16x32_bf16(kfr[kq], vfr[dq], accST[kq][dq], 0, 0, 0); }
        __syncthreads();
        if (latent) {
#pragma unroll
            for (int tq = 0; tq < 4; ++tq)
#pragma unroll
                for (int tf = 0; tf < 2; ++tf) { const int t = wm * 32 + tf * 16 + l15, tp0 = 16 * (wn * 4 + tq) + 4 * lq;
                    u32x2 pk; pk.x = cvt_pk_bf16(accS[tq][tf][0], accS[tq][tf][1]); pk.y = cvt_pk_bf16(accS[tq][tf][2], accS[tq][tf][3]);
                    CK(ck1, pk.x); CK(ck1, pk.y);
                    *(LAS u32x2*)(Qs + off_b(t, tp0 >> 3) + (tp0 & 7) * 2) = pk; }
        }
#pragma unroll
        for (int kq = 0; kq < 2; ++kq)
#pragma unroll
            for (int dq = 0; dq < 2; ++dq) { const int row = 16 * (db * 2 + dq) + l15, dk0 = 16 * (kb * 2 + kq) + 4 * lq;
                u32x2 pk; pk.x = cvt_pk_bf16(accST[kq][dq][0], accST[kq][dq][1]); pk.y = cvt_pk_bf16(accST[kq][dq][2], accST[kq][dq][3]);
                CK(ck2, pk.x); CK(ck2, pk.y);
                *(LAS u32x2*)(STs + off_b(row, dk0 >> 3) + (dk0 & 7) * 2) = pk; }
        if (tjob) { const u32x6 tpk = pack_fp6(tv, tjb < 8 ? PEER_SU : PEER_SV); unsigned char* tdst = (tjb < 8 ? t6u : t6v) + trow * 1536;
            *(u32x4*)(tdst + 16 * lane) = (u32x4){tpk[0], tpk[1], tpk[2], tpk[3]}; *(u32x2*)(tdst + 1024 + 8 * lane) = (u32x2){tpk[4], tpk[5]}; }
        if (step + 1 < 34) RET_LOAD(step + 1);
        __syncthreads();
        if (latent) {
#pragma unroll
            for (int ks = 0; ks < 4; ++ks) { bf16x8 vf[2], sfr[2];
#pragma unroll
                for (int q = 0; q < 2; ++q) { vf[q] = trfrag(Vs, lane, wn * 2 + q, ks); sfr[q] = rowfrag(Qs, lane, wm * 2 + q, ks); }
#pragma unroll
                for (int dq = 0; dq < 2; ++dq)
#pragma unroll
                    for (int tf = 0; tf < 2; ++tf) accC[dq][tf] = __builtin_amdgcn_mfma_f32_16x16x32_bf16(vf[dq], sfr[tf], accC[dq][tf], 0, 0, 0); }
#pragma unroll
            for (int dq = 0; dq < 2; ++dq)
#pragma unroll
                for (int tf = 0; tf < 2; ++tf) { const int t = wm * 32 + tf * 16 + l15, dv0 = 16 * (wn * 2 + dq) + 4 * lq;
                    u32x2 pk; pk.x = cvt_pk_bf16(accC[dq][tf][0], accC[dq][tf][1]); pk.y = cvt_pk_bf16(accC[dq][tf][2], accC[dq][tf][3]);
                    CK(ck3, pk.x); CK(ck3, pk.y);
                    *(u32x2*)(Oout + (lr0 + t) * 2048 + h * 256 + dvq * 64 + dv0) = pk; }
        }
    }
    __syncthreads();
    if (dbg && dir == 0) { atomicAdd(dbg + 16, ck0); atomicAdd(dbg + 17, ck1); atomicAdd(dbg + 18, ck2); atomicAdd(dbg + 19, ck3); }
#undef CK
}
}

__device__ __forceinline__ void phase5(const Args& A, int G, int lane, int wave) {
    const int gw = blockIdx.x * 8 + wave, NGW = G * 8;
    unsigned char* ws = A.ws;
    const bf16_t *OF = (const bf16_t*)(ws + WS_OF), *OB = (const bf16_t*)(ws + WS_OB), *GR = (const bf16_t*)(ws + WS_GR); bf16_t* RET = (bf16_t*)(ws + WS_RET);
    const float* rw = A.in[12];
    float* rsO = (float*)(ws + WS_RS) + 32768; float* rsR = (float*)(ws + WS_RS) + 65536;
    const bf16_t* OA = (const bf16_t*)(ws + WS_OATT); unsigned char* OA8 = ws + WS_OATT8; unsigned char* RET8 = (unsigned char*)RET;
    for (int r = gw; r < 2048; r += NGW) { const bf16_t* wr_ = (const bf16_t*)(ws + WS_W2) + (size_t)r * 2048; f32x4 y[8]; float am = 0.f;
#pragma unroll
        for (int j = 0; j < 8; ++j) { const u32x2 q = *(const u32x2*)(wr_ + 4 * lane + 256 * j); y[j] = (f32x4){bf_lo(q.x), bf_hi(q.x), bf_lo(q.y), bf_hi(q.y)};
            am = fmaxf(fmaxf(am, fmaxf(fabsf(y[j].x), fabsf(y[j].y))), fmaxf(fabsf(y[j].z), fabsf(y[j].w))); }
        am = fmaxf(wave_max(am), 1e-20f); const float qs = 127.f / am; if (lane == 0) ((float*)(ws + WS_RS))[98304 + r] = am * (1.f / 127.f);
#pragma unroll
        for (int j = 0; j < 8; ++j) *(unsigned*)(ws + WS_W2Q + (size_t)r * 2048 + 4 * lane + 256 * j) = q4_i8(y[j] * qs); }
    for (int r = gw; r < ML; r += NGW) {
        const size_t base = (size_t)r * 2048;
        f32x4 y[8]; float am = 0.f, ssr = 0.f;
#pragma unroll
        for (int j = 0; j < 8; ++j) { const int c = 4 * lane + 256 * j;
            const u32x2 a = *(const u32x2*)(OF + base + c), bq = *(const u32x2*)(OB + base + c), g = *(const u32x2*)(GR + base + c);
            f32x4 o = {bf_lo(a.x) + bf_lo(bq.x), bf_hi(a.x) + bf_hi(bq.x), bf_lo(a.y) + bf_lo(bq.y), bf_hi(a.y) + bf_hi(bq.y)};
            const float mu = wave_allsum((o.x + o.y) + (o.z + o.w)) * (1.f / 256.f);
            o = o - mu;
            const float var = wave_allsum((o.x * o.x + o.y * o.y) + (o.z * o.z + o.w * o.w)) * (1.f / 256.f);
            const float rstd = rsqrtf(var + EPS);
            const f32x4 wv = *(const f32x4*)(rw + c);
            y[j] = o * rstd * wv * (f32x4){bf_lo(g.x), bf_hi(g.x), bf_lo(g.y), bf_hi(g.y)}; ssr += (y[j].x * y[j].x + y[j].y * y[j].y) + (y[j].z * y[j].z + y[j].w * y[j].w);
            am = fmaxf(fmaxf(am, fmaxf(fabsf(y[j].x), fabsf(y[j].y))), fmaxf(fabsf(y[j].z), fabsf(y[j].w))); }
        am = fmaxf(wave_max(am), 1e-20f); { const float qs = 127.f / am; if (lane == 0) rsR[r] = am * (1.f / 127.f);
#pragma unroll
            for (int j = 0; j < 8; ++j) *(unsigned*)(RET8 + base + 4 * lane + 256 * j) = q4_i8(y[j] * qs); }
        { const u32x4 w0 = *(const u32x4*)(OA + (size_t)r * 1024 + 8 * lane), w1 = *(const u32x4*)(OA + (size_t)r * 1024 + 512 + 8 * lane);
          float a2 = 0.f, sso = 0.f;
#pragma unroll
          for (int q = 0; q < 4; ++q) { a2 = fmaxf(fmaxf(a2, fmaxf(fabsf(bf_lo(w0[q])), fabsf(bf_hi(w0[q])))), fmaxf(fabsf(bf_lo(w1[q])), fabsf(bf_hi(w1[q]))));
              sso += (bf_lo(w0[q]) * bf_lo(w0[q]) + bf_hi(w0[q]) * bf_hi(w0[q])) + (bf_lo(w1[q]) * bf_lo(w1[q]) + bf_hi(w1[q]) * bf_hi(w1[q])); }
          { const float sb = sqrtf(wave_allsum(sso) * (1.f / 1024.f) + wave_allsum(ssr) * (1.f / 2048.f)); const float mx = fmaxf(4.f * sb, 1e-20f);
            if (lane == 0) { ((float*)(ws + WS_RS))[163840 + r] = mx * (1.f / 127.f); ((float*)(ws + WS_RS))[180224 + r] = 127.f / mx; } }
          a2 = fmaxf(wave_max(a2), 1e-20f); const float qs = 127.f / a2; if (lane == 0) rsO[r] = a2 * (1.f / 127.f);
          u32x2 o0, o1;
          o0.x = q4_i8((f32x4){bf_lo(w0.x), bf_hi(w0.x), bf_lo(w0.y), bf_hi(w0.y)} * qs); o0.y = q4_i8((f32x4){bf_lo(w0.z), bf_hi(w0.z), bf_lo(w0.w), bf_hi(w0.w)} * qs);
          o1.x = q4_i8((f32x4){bf_lo(w1.x), bf_hi(w1.x), bf_lo(w1.y), bf_hi(w1.y)} * qs); o1.y = q4_i8((f32x4){bf_lo(w1.z), bf_hi(w1.z), bf_lo(w1.w), bf_hi(w1.w)} * qs);
          *(u32x2*)(OA8 + (size_t)r * 1024 + 8 * lane) = o0; *(u32x2*)(OA8 + (size_t)r * 1024 + 512 + 8 * lane) = o1; }
    }
}

__device__ __forceinline__ void phase9(const Args& A, int G, int tid, int lane, int wave) {
    const int gw = blockIdx.x * 8 + wave, NGW = G * 8;
    unsigned char* ws = A.ws;
    const float* modacc = (const float*)(ws + WS_CTL) + CW_MOD; const bf16_t* X1 = (const bf16_t*)(ws + WS_X1); bf16_t* H2 = (bf16_t*)(ws + WS_H2);
    for (int r = gw; r < ML; r += NGW) { const float* md = modacc + (r / SEQ) * 12288;
        norm_mod_row<1, true>((const float*)(X1 + (size_t)r * DM), A.in[16], md + 3 * 2048, md + 4 * 2048, (bf16_t*)(ws + WS_H2Q + (size_t)r * DM), lane, (float*)(ws + WS_RS) + 131072 + r); }
}

__device__ __forceinline__ float med3f(float a, float b, float c) { return __builtin_amdgcn_fmed3f(a, b, c); }
#define TOPK_INSERT(L, key) do { _Pragma("unroll") for (int _j = 15; _j >= 1; --_j) L[_j] = med3f(L[_j], L[_j - 1], (key)); L[0] = fmaxf(L[0], (key)); } while (0)
__device__ __forceinline__ float gelu_tanh(float a) { const float z = 0.7978845608028654f * (a + 0.044715f * a * a * a); const float t = 1.f - 2.f * __builtin_amdgcn_rcpf(1.f + __expf(2.f * z)); return 0.5f * a * (1.f + t); }
__device__ __forceinline__ void phase12(const Args& A, LAS unsigned char* lds, int G, int tid, int lane, int wave) {
    unsigned char* ws = A.ws;
    const _Float16* SCT = (const _Float16*)(ws + WS_SCT); const bf16_t* X1 = (const bf16_t*)(ws + WS_X1); const unsigned char* H2Q = ws + WS_H2Q; const float* rsH2 = (const float*)(ws + WS_RS) + 131072;
    const unsigned char* U8 = ws + WS_U; const unsigned char* V8 = ws + WS_V;
    const float* modacc = (const float*)(ws + WS_CTL) + CW_MOD; const float* nfw = A.in[21];
    LAS unsigned* ab = (LAS unsigned*)lds;
    LAS unsigned* res_e = (LAS unsigned*)(lds + 65536);
    LAS float* res_g = (LAS float*)(lds + 65536 + 33024);
    LAS unsigned* srt_e = (LAS unsigned*)lds;
    LAS float* srt_g = (LAS float*)(lds + 32768);
    LAS float* act_s = srt_g; LAS unsigned* act_u = (LAS unsigned*)srt_g;
    LAS float* a_s = (LAS float*)(lds + 65536);
    LAS unsigned* offs = (LAS unsigned*)(lds + 65536 + 2 * 33024);
    if (G != ML / 64) return;
    { const int tb = blockIdx.x;
        const int t0 = tb * 64;
        __syncthreads();
        {
            const int h = wave; const _Float16* sp = SCT + (size_t)(h * 256) * ML + t0 + lane;
            float La[16], Lb[16], Lc[16];
#pragma unroll
            for (int i = 0; i < 16; ++i) { La[i] = -INFINITY; Lb[i] = -INFINITY; Lc[i] = -INFINITY; }
#pragma unroll 32
            for (int n = 0; n < 128; ++n) { const float s = (float)sp[(size_t)n * ML]; const float key = __uint_as_float((__float_as_uint(s) & ~127u) | (unsigned)n); TOPK_INSERT(La, key); }
#pragma unroll 32
            for (int n = 0; n < 128; ++n) { const float s = (float)sp[(size_t)(128 + n) * ML]; const float key = __uint_as_float((__float_as_uint(s) & ~127u) | (unsigned)n); TOPK_INSERT(Lb, key); }
#pragma unroll
            for (int i = 0; i < 16; ++i) { ab[i * 512 + tid] = __float_as_uint(La[i]); ab[(16 + i) * 512 + tid] = __float_as_uint(Lb[i]); }
#pragma unroll
            for (int i = 0; i < 16; ++i)
#pragma unroll
                for (int j = 0; j < 16; ++j) if ((i + 1) * (j + 1) <= 16) { const float c = La[i] + Lb[j]; const float key = __uint_as_float((__float_as_uint(c) & ~255u) | (unsigned)(i * 16 + j)); TOPK_INSERT(Lc, key); }
            float p[16], sum = 0.f;
#pragma unroll
            for (int k = 0; k < 16; ++k) { p[k] = __expf(Lc[k] - Lc[0]); sum += p[k]; }
            const float inv = 1.f / sum;
            int lane3 = lane; asm volatile("" : "+v"(lane3));
            const int rbase = lane3 * 129 + h * 16;
#pragma unroll
            for (int k = 0; k < 16; ++k) { const unsigned code = __float_as_uint(Lc[k]) & 255u; const unsigned ia = ab[(code >> 4) * 512 + tid] & 127u, ib = ab[(16 + (code & 15u)) * 512 + tid] & 127u;
                res_e[rbase + k] = ia * 128u + ib; res_g[rbase + k] = p[k] * inv; }
        }
        __syncthreads();
        {
            int lane_ = tid & 63; asm volatile("" : "+v"(lane_)); const int lane = lane_;
            const int tl0 = wave * 8;
#pragma unroll 1
            for (int j = 0; j < 8; ++j) { const int tl = tl0 + j;
                const unsigned e0 = res_e[tl * 129 + lane], e1 = res_e[tl * 129 + 64 + lane]; const float g0 = res_g[tl * 129 + lane], g1 = res_g[tl * 129 + 64 + lane];
                const unsigned s0 = e0 >> 9, s1 = e1 >> 9; unsigned pos0 = 0, pos1 = 0; unsigned off = 0;
#pragma unroll 1
                for (unsigned bb = 0; bb < 32; ++bb) { const unsigned long long m0 = __ballot(s0 == bb), m1 = __ballot(s1 == bb);
                    const unsigned c0 = __popcll(m0), c1 = __popcll(m1);
                    const unsigned r0 = __builtin_amdgcn_mbcnt_hi((unsigned)(m0 >> 32), __builtin_amdgcn_mbcnt_lo((unsigned)m0, 0u)), r1 = __builtin_amdgcn_mbcnt_hi((unsigned)(m1 >> 32), __builtin_amdgcn_mbcnt_lo((unsigned)m1, 0u));
                    if (s0 == bb) pos0 = off + r0; if (s1 == bb) pos1 = off + c0 + r1;
                    if (lane == 0) offs[tl * 33 + bb] = off;
                    off += c0 + c1; }
                if (lane == 0) offs[tl * 33 + 32] = off;
                srt_e[tl * 128 + pos0] = e0; srt_g[tl * 128 + pos0] = g0; srt_e[tl * 128 + pos1] = e1; srt_g[tl * 128 + pos1] = g1; }
            __syncthreads();
            const int cc = lane & 15, gg = lane >> 4, l32 = lane & 31, hw = lane >> 5;
            f32x4 dmask; { const bool vd = (cc >> 2) == gg; dmask[0] = (vd && (cc & 3) == 0) ? 1.f : 0.f; dmask[1] = (vd && (cc & 3) == 1) ? 1.f : 0.f; dmask[2] = (vd && (cc & 3) == 2) ? 1.f : 0.f; dmask[3] = (vd && (cc & 3) == 3) ? 1.f : 0.f; }
            const unsigned l16 = 16u * (unsigned)lane, l8 = 1024u + 8u * (unsigned)lane;
#define U64(v, h) ((long)(((unsigned long long)(v)[2 * (h) + 1] << 32) | (v)[2 * (h)]))
            {
#pragma unroll 1
              for (int gu = 0; gu < 2; ++gu) {
                const int tlu = tl0 + 4 * gu;
                i32x8 hq[4]; float hinv[4];
#pragma unroll
                for (int t8 = 0; t8 < 4; ++t8) { const size_t tk = (size_t)t0 + tlu + t8; f32x4 v[8];
#pragma unroll
                    for (int i = 0; i < 8; ++i) { const unsigned hv = *(const unsigned*)(H2Q + tk * 2048 + 256 * i + 4 * lane);
                        v[i] = (f32x4){(float)(int)(signed char)(hv & 255u), (float)(int)(signed char)((hv >> 8) & 255u), (float)(int)(signed char)((hv >> 16) & 255u), (float)((int)hv >> 24)}; }
                    hinv[t8] = rsH2[tk] * (127.f / (7.5f * PEER_SU));
                    const u32x6 pk = pack_fp6(v, 7.5f / 127.f); hq[t8] = (i32x8){(int)pk[0], (int)pk[1], (int)pk[2], (int)pk[3], (int)pk[4], (int)pk[5], 0, 0}; }
                u32x4 ur4[4][UQ]; u32x2 ur2[4][UQ];
#define UP_LD(T, C) do { _Pragma("unroll") for (int q = 0; q < UQ; ++q) { const unsigned e_ = __builtin_amdgcn_readfirstlane(srt_e[(tlu + (T)) * 128 + UQ * (C) + q]); \
            const unsigned ro_ = e_ * 1536u; ur4[T][q] = *(const u32x4*)(U8 + (ro_ + l16)); ur2[T][q] = *(const u32x2*)(U8 + (ro_ + l8)); } } while (0)
#define UP_MM(T, C) do { f32x4 P_[UQ]; \
            _Pragma("unroll") for (int q = 0; q < UQ; ++q) { const i32x8 A_ = {(int)ur4[T][q].x, (int)ur4[T][q].y, (int)ur4[T][q].z, (int)ur4[T][q].w, (int)ur2[T][q].x, (int)ur2[T][q].y, 0, 0}; \
                P_[q] = __builtin_amdgcn_mfma_scale_f32_16x16x128_f8f6f4(A_, hq[T], (f32x4){0.f, 0.f, 0.f, 0.f}, 2, 2, 0, 127, 0, 127); } \
            float r_[UQ]; _Pragma("unroll") for (int q = 0; q < UQ; ++q) r_[q] = (P_[q][0] * dmask[0] + P_[q][1] * dmask[1]) + (P_[q][2] * dmask[2] + P_[q][3] * dmask[3]); \
            _Pragma("unroll") for (int q = 0; q < UQ; ++q) r_[q] += dpp_row_shr(r_[q], 1); \
            _Pragma("unroll") for (int q = 0; q < UQ; ++q) r_[q] += dpp_row_shr(r_[q], 2); \
            _Pragma("unroll") for (int q = 0; q < UQ; ++q) r_[q] += dpp_row_shr(r_[q], 4); \
            _Pragma("unroll") for (int q = 0; q < UQ; ++q) r_[q] += dpp_row_shr(r_[q], 8); \
            _Pragma("unroll") for (int q = 0; q < UQ; ++q) r_[q] += __builtin_bit_cast(float, __builtin_amdgcn_update_dpp(0, __builtin_bit_cast(int, r_[q]), 0x142, 0xa, 0xf, false)); \
            _Pragma("unroll") for (int q = 0; q < UQ; ++q) r_[q] += __builtin_bit_cast(float, __builtin_amdgcn_update_dpp(0, __builtin_bit_cast(int, r_[q]), 0x143, 0xc, 0xf, false)); \
            if (lane == 63) { _Pragma("unroll") for (int q = 0; q < UQ; ++q) a_s[(tlu + (T)) * 128 + UQ * (C) + q] = r_[q] * hinv[T]; } } while (0)
                UP_LD(0, 0); UP_LD(1, 0); UP_LD(2, 0); UP_LD(3, 0);
#pragma unroll 1
                for (int c = 0; c < 128 / UQ - 1; ++c) {
                    if ((c & (2 * PEER_SYNC / UQ - 1)) == 0) __builtin_amdgcn_s_barrier();
                    UP_MM(0, c); UP_LD(0, c + 1);
                    UP_MM(1, c); UP_LD(1, c + 1);
                    UP_MM(2, c); UP_LD(2, c + 1);
                    UP_MM(3, c); UP_LD(3, c + 1);
                }
                UP_MM(0, 128 / UQ - 1); UP_MM(1, 128 / UQ - 1); UP_MM(2, 128 / UQ - 1); UP_MM(3, 128 / UQ - 1);
#undef UP_LD
#undef UP_MM
              }
#pragma unroll 1
                for (int t8 = 0; t8 < 8; ++t8) { const int bi = (tl0 + t8) * 128 + lane;
                    const float a0 = a_s[bi], a1 = a_s[bi + 64];
                    act_s[bi] = gelu_tanh(a0) * srt_g[bi]; act_s[bi + 64] = gelu_tanh(a1) * srt_g[bi + 64]; }
            }
#pragma unroll 1
            for (int grp = 0; grp < 2; ++grp) {
                f32x4 o[4][8];
#pragma unroll
                for (int t4 = 0; t4 < 4; ++t4)
#pragma unroll
                    for (int i = 0; i < 8; ++i) o[t4][i] = (f32x4){0.f, 0.f, 0.f, 0.f};
                const int tlg = tl0 + 4 * grp;
                u32x4 vr4[4][2]; u32x2 vr2[4][2];
#define VP_LD(T, C) do { const u32x2 ee_ = *(const LAS u32x2*)(srt_e + (tlg + (T)) * 128 + 2 * (C)); \
            _Pragma("unroll") for (int q = 0; q < 2; ++q) { const unsigned ro_ = (unsigned)__builtin_amdgcn_readfirstlane(ee_[q]) * 1536u; \
            vr4[T][q] = *(const u32x4*)(V8 + (ro_ + l16)); vr2[T][q] = *(const u32x2*)(V8 + (ro_ + l8)); } } while (0)
#define VP_MM(T, C) do { const u32x2 aa_ = *(const LAS u32x2*)(act_u + (tlg + (T)) * 128 + 2 * (C)); \
            _Pragma("unroll") for (int q = 0; q < 2; ++q) { const float ac_ = __uint_as_float(__builtin_amdgcn_readfirstlane(aa_[q])); \
            const u32x6 pk_ = {vr4[T][q].x, vr4[T][q].y, vr4[T][q].z, vr4[T][q].w, vr2[T][q].x, vr2[T][q].y}; f32x32 r_ = __builtin_amdgcn_cvt_scalef32_pk32_f32_fp6(pk_, 1.0f); \
            _Pragma("unroll") for (int i = 0; i < 8; ++i) o[T][i] += (f32x4){r_[4 * i], r_[4 * i + 1], r_[4 * i + 2], r_[4 * i + 3]} * ac_; } } while (0)
                VP_LD(0, 0); VP_LD(1, 0); VP_LD(2, 0); VP_LD(3, 0);
#pragma unroll 1
                for (int c = 0; c < 63; ++c) {
                    if ((c & (PEER_SYNC - 1)) == 0) __builtin_amdgcn_s_barrier();
                    VP_MM(0, c); VP_LD(0, c + 1);
                    VP_MM(1, c); VP_LD(1, c + 1);
                    VP_MM(2, c); VP_LD(2, c + 1);
                    VP_MM(3, c); VP_LD(3, c + 1);
                }
                VP_MM(0, 63); VP_MM(1, 63); VP_MM(2, 63); VP_MM(3, 63);
                __builtin_amdgcn_sched_barrier(0);
#undef VP_LD
#undef VP_MM
                int le_ = threadIdx.x & 63; asm volatile("" : "+v"(le_));
#pragma unroll
                for (int t4 = 0; t4 < 4; ++t4) { const size_t tk = (size_t)t0 + tl0 + 4 * grp + t4;
                    __builtin_amdgcn_sched_barrier(0);
                    const float* md = modacc + (tk / SEQ) * 12288 + 5 * 2048; float ss = 0.f;
#pragma unroll
                    for (int i = 0; i < 8; ++i) { const int c = 256 * i + 4 * le_; const u32x2 xq_ = *(const u32x2*)(X1 + tk * 2048 + c); const f32x4 x1 = {bf_lo(xq_.x), bf_hi(xq_.x), bf_lo(xq_.y), bf_hi(xq_.y)}, g = *(const f32x4*)(md + c);
                        const f32x4 x2 = x1 + g * (o[t4][i] * (1.f / PEER_SV)); o[t4][i] = x2; ss += (x2.x * x2.x + x2.y * x2.y) + (x2.z * x2.z + x2.w * x2.w); }
                    const float rstd = rsqrtf(wave_allsum(ss) * (1.f / 2048.f) + EPS);
#pragma unroll
                    for (int i = 0; i < 8; ++i) { const int c = 256 * i + 4 * le_; const f32x4 wv = *(const f32x4*)(nfw + c);
                        *(f32x4*)(A.out + tk * 2048 + c) = o[t4][i] * rstd * wv; } }
            }
#undef U64
        }
    }
}

struct Sched1 {
    int G, c; const char* A; const char* B;
    __device__ __forceinline__ bool next(int i, pg8::Unit& u) const {
        constexpr int NU = 3000, NL = 2944;
        const long L = (long)i * G + c; if (L >= NU) return false;
        int wgid = (int)L; { const int q = NU / 8, xcd = wgid % 8, off = wgid / 8; wgid = xcd * q + off; }
        int pm, pn;
        if (wgid < NL) { const int gid = wgid / 368, wq = wgid % 368, lt = gid * 8 + (wq % 8); pn = wq / 8; pm = (lt / 16) * 17 + 1 + (lt % 16); }
        else { const int wq = wgid - NL, cb = wq % 4, ci = wq / 4; pm = cb * 17; pn = ci < 2 ? 4 + ci : 8 + ci; }
        u.pm = pm; u.pn = pn; u.a = A + (size_t)pm * (256 * 2048); u.b = B + (size_t)pn * (256 * 2048); return true;
    }
};
struct SchedS {
    int G, c; const char* KBD; const char* PQ;
    __device__ __forceinline__ bool next(int i, pg8::Unit& u) const {
        const int L = i * G + c; if (L >= 512) return false;
        const int j = L & 7, tt = L >> 3; u.pm = j; u.pn = tt; u.a = KBD + (size_t)j * (256 * 256 * 2); u.b = PQ + ((size_t)tt * 256 * 2048 + (size_t)j * 256) * 2; return true;
    }
};


#ifdef MK_DEBUG
__device__ __forceinline__ void dbg_scan(unsigned* ctl, int pass, int flag, const void* ptr, size_t nbytes, int G, int tid) {
    const size_t gt = (size_t)blockIdx.x * 512 + tid, NT = (size_t)G * 512; unsigned acc = 0u;
    const unsigned* p = (const unsigned*)ptr; const size_t n = nbytes / 4; for (size_t i = gt; i < n; i += NT) { const unsigned v = p[i]; acc += v * 2654435761u + (v >> 7); }
    atomicAdd(ctl + CW_DBG + 64 * pass + flag, acc);
}
#define DBG_SCAN(flag, off, bytes, f32) dbg_scan(ctl, args.pass, flag, ws + (off), (size_t)(bytes), G, tid)
#else
#define DBG_SCAN(flag, off, bytes, f32) do {} while (0)
#endif
struct SchedW2 {
    int G, c; const char* KBD; const char* WQ;
    __device__ __forceinline__ bool next(int i, pg8::Unit& u) const {
        const int L = i * G + c; if (L >= 64) return false;
        const int j = L & 7, dt = L >> 3; u.pm = j; u.pn = dt; u.a = KBD + (size_t)j * (256 * 256 * 2); u.b = WQ + ((size_t)dt * 256 * 2048 + (size_t)j * 256) * 2; return true;
    }
};
constexpr int NPH = 13;
__global__ void __launch_bounds__(512, 2) mk_fwd(Args args) {
    extern __shared__ __attribute__((aligned(16))) unsigned char lds_raw[];
    LAS unsigned char* lds = (LAS unsigned char*)lds_raw;
    volatile LAS unsigned* MISC = (volatile LAS unsigned*)(lds + MISC_OFF);
    const int wave = __builtin_amdgcn_readfirstlane(threadIdx.x >> 6), G = gridDim.x;
#define FRESH_TID int tid_ = threadIdx.x; asm volatile("" : "+v"(tid_)); const int tid = tid_, lane = tid & 63; (void)lane
    unsigned char* ws = args.ws;
    unsigned* ctl = (unsigned*)(ws + WS_CTL);
    for (int u = threadIdx.x; u < (LDS_BYTES - RING_BYTES) / 4; u += 512) ((LAS unsigned*)(lds + RING_BYTES))[u] = 0u;
    __syncthreads();
    XcdBarrier bar; bar.bar = ctl + CW_BAR; bar.x = 0; bar.st = nullptr;
    if (MK_N_LAUNCHES == 1) bar = xcd_barrier_post(ctl + CW_BAR, MISC + 8);
    const int lo = args.ph_lo, hi = args.ph_hi;
#ifndef PH_MASK
#define PH_MASK 0x1fff
#endif
#define IN(k) (((PH_MASK >> (k)) & 1) && lo <= (k) && (k) < hi)
#define SEAM(k) do { if (IN(k) && (k) + 1 < hi) xcd_barrier(bar); } while (0)
    const int bx = blockIdx.x;

#ifdef MK_DEBUG
    if (lo >= 100) {
        const int k = lo - 100;
        if (k == 0) { DBG_SCAN(0, WS_WIN, 75 * MiB, false); DBG_SCAN(0, WS_ROPE, 2 * MiB, true); DBG_SCAN(0, WS_CTL + CW_MOD * 4, 5 * 12288 * 4, true); }
        if (k == 1) DBG_SCAN(1, WS_HN, (size_t)MT * 2048 * 2, false);
        if (k == 2) DBG_SCAN(2, WS_QA, 375 * MiB, false);
        if (k == 3) DBG_SCAN(3, WS_QA, 115 * MiB, false);
        if (k == 4) { DBG_SCAN(4, WS_OATT, 32 * MiB, false); DBG_SCAN(12, WS_OF, 64 * MiB, false); DBG_SCAN(13, WS_OB, 64 * MiB, false); }
        if (k == 5) DBG_SCAN(5, WS_RET, 64 * MiB, false);
        if (k == 6) DBG_SCAN(6, WS_T, 64 * MiB, false);
        if (k == 7) DBG_SCAN(7, WS_MIX, 64 * MiB, false);
        if (k == 8) DBG_SCAN(8, WS_X1, 128 * MiB, true);
        if (k == 9) { DBG_SCAN(9, WS_H2, 64 * MiB, false); DBG_SCAN(9, WS_U, 128 * MiB, false); }
        if (k == 10) DBG_SCAN(10, WS_PQ, 64 * MiB, false);
        if (k == 11) DBG_SCAN(11, WS_SCT, 128 * MiB, true);
        return;
    }
#endif

    if (IN(0)) { FRESH_TID; phase0(args, lds, G, tid, lane, wave); } SEAM(0);
    if (IN(1)) {
        {
            pg8::Gemm g{256, 2048, 256, nullptr, 0.f}; SchedW2 S{G, bx, (const char*)(ws + WS_KBD), (const char*)(ws + WS_WPQ)};
            pg8::EpiB<0> E{(bf16_t*)(ws + WS_W2), 2048, nullptr, nullptr};
            pg8::gemm_phase<pg8::EpiB<0>, SchedW2, false, false>(lds, g, S, E);
        }
        FRESH_TID; phase1(args, G, lane, wave); } SEAM(1);
    if (IN(2)) {
        pg8::Gemm g{1024, 1024, 1024, (const float*)(ws + WS_RS), 1.f / QW_2048}; Sched1 S{G, bx, (const char*)(ws + WS_HN), (const char*)(ws + WS_WIN)};
        pg8::EpiRoute E{(bf16_t*)(ws + WS_QA), (bf16_t*)(ws + WS_KA), (bf16_t*)(ws + WS_VA), (bf16_t*)(ws + WS_QR), (bf16_t*)(ws + WS_KR), (bf16_t*)(ws + WS_VR), (bf16_t*)(ws + WS_GR), (bf16_t*)(ws + WS_GA), (bf16_t*)(ws + WS_GT),
                        (const float*)(ws + WS_NWP), (const float*)(ws + WS_NWP) + 128, (const float*)(ws + WS_ROPE), (PG8_LAS float*)(lds + RING_BYTES)};
        pg8::gemm_phase<pg8::EpiRoute, Sched1, true, true, true>(lds, g, S, E);

    } SEAM(2);
    if (IN(3)) {
        const int x = bx & 7, c = bx >> 3;
        if (G == 256) {
            const int b = x >> 1, kvh = x & 1;
            float mfix; bool fixed_ok;
            { int l_ = threadIdx.x & 63; asm volatile("" : "+v"(l_)); const float wq_ = fmaxf(fabsf(args.in[8][l_]), fabsf(args.in[8][l_ + 64])), wk_ = fmaxf(fabsf(args.in[9][l_]), fabsf(args.in[9][l_ + 64]));
              mfix = 128.f * wave_max(wq_) * wave_max(wk_); mfix = __uint_as_float(__builtin_amdgcn_readfirstlane(__float_as_uint(mfix))); fixed_ok = mfix * att::SCALE < 40.f; }
#ifndef NO_ATT
#pragma unroll 1
            for (int i = 0; i < 2; ++i) { const int uu = c * 2 + i, h = kvh * 4 + (uu >> 4), qb = uu & 15;
                const bf16_t* q = (const bf16_t*)(ws + WS_QA) + ((size_t)(b * SEQ + qb * 256)) * 1024 + h * 128; const bf16_t* k = (const bf16_t*)(ws + WS_KA) + (size_t)(b * LT) * 256 + kvh * 128;
                const bf16_t* v = (const bf16_t*)(ws + WS_VA) + (size_t)(b * LT) * 256 + kvh * 128; bf16_t* o = (bf16_t*)(ws + WS_OATT) + ((size_t)(b * SEQ + qb * 256)) * 1024 + h * 128;
                asm volatile("" : "+s"(q), "+s"(k), "+s"(v), "+s"(o) :: "memory");
                if (fixed_ok) att::attn_dense_body<true>(q, k, v, o, LT, (char*)lds_raw, mfix); else att::attn_dense_body<false>(q, k, v, o, LT, (char*)lds_raw, 0.f); }
#endif
#ifndef NO_RET
            const int gi = x * 4 + (c >> 3), rb = gi >> 3, rh = gi & 7, sub = c & 7, dir = sub >> 2, dvq = sub & 3;
            ret::unit(lds, rb, rh, dir, dvq, (const bf16_t*)(ws + WS_QR), (const bf16_t*)(ws + WS_KR), (const bf16_t*)(ws + WS_VR), (bf16_t*)(ws + (dir ? WS_OB : WS_OF)), args.in[dir ? 11 : 10][rh],
#ifdef MK_DEBUG
                      ctl + CW_DBG + 64 * args.pass
#else
                      nullptr
#endif
                      , args.in[19], args.in[20], ws + WS_U, ws + WS_V);
#endif
        }

    } SEAM(3);
    if (IN(4)) { FRESH_TID; phase5(args, G, lane, wave); } SEAM(4);
    if (IN(5)) {
        pg8::Gemm g{512, 512, 512, (const float*)(ws + WS_RS) + 32768, 1.f / QW_1024}; pg8::PlainSched S{64, 8, G, bx, (const char*)(ws + WS_OATT8), (const char*)(ws + WS_WAB), (size_t)256 * 1024, (size_t)256 * 1024};
        pg8::EpiB<1> E{(bf16_t*)(ws + WS_T), 2048, (const bf16_t*)(ws + WS_GA), nullptr};
        pg8::gemm_phase<pg8::EpiB<1>, pg8::PlainSched, true, true, true>(lds, g, S, E);

    }
    if (IN(6)) {
        pg8::Gemm g{1024, 1024, 1024, (const float*)(ws + WS_RS) + 65536, 1.f / QW_2048}; pg8::PlainSched S{64, 8, G, bx, (const char*)(ws + WS_RET), (const char*)(ws + WS_WRB), (size_t)256 * 2048, (size_t)256 * 2048};
        pg8::EpiMixQ E{ws + WS_MIXQ, ws + WS_GT, (const bf16_t*)(ws + WS_T), (const float*)(ws + WS_RS) + 180224};
        pg8::gemm_phase<pg8::EpiMixQ, pg8::PlainSched, true, true, true>(lds, g, S, E);

    } SEAM(6);
    if (IN(8)) {
        pg8::Gemm g{1024, 1024, 1024, (const float*)(ws + WS_RS) + 163840, 1.f / QW_2048}; pg8::PlainSched S{64, 8, G, bx, (const char*)(ws + WS_MIXQ), (const char*)(ws + WS_WMO), (size_t)256 * 2048, (size_t)256 * 2048};
        pg8::EpiX E{(bf16_t*)(ws + WS_X1), args.in[0], (const float*)(ws + WS_CTL) + CW_MOD + 2 * 2048};
        pg8::gemm_phase<pg8::EpiX, pg8::PlainSched, true, true, true>(lds, g, S, E);
    } SEAM(8);
    if (IN(9)) {
        FRESH_TID; phase9(args, G, tid, lane, wave);
    } SEAM(9);
    if (IN(10)) {
        pg8::Gemm g{1024, 1024, 1024, (const float*)(ws + WS_RS) + 98304, 1.f}; pg8::PlainSched S{8, 64, G, bx, (const char*)(ws + WS_W2Q), (const char*)(ws + WS_H2Q), (size_t)256 * 2048, (size_t)256 * 2048};
        pg8::EpiH E{(_Float16*)(ws + WS_SCT), ML, (const float*)(ws + WS_RS) + 131072};
        pg8::gemm_phase<pg8::EpiH, pg8::PlainSched, true, true, true>(lds, g, S, E);
    } SEAM(10);
    if (IN(12)) { FRESH_TID; phase12(args, lds, G, tid, lane, wave); }
#undef IN
#undef SEAM
}

extern "C" void kernel_launch(void* const* d_in, const int* in_sizes, int n_in, void* d_out, int out_size, void* d_ws, size_t ws_size, hipStream_t stream) {
    static int grid = 0;
    if (grid == 0) {
        if (n_in != 22 || in_sizes[0] != ML * DM || out_size != ML * DM || ws_size < WS_END) { fprintf(stderr, "kernel_launch: shape/workspace mismatch (n_in %d, in0 %d, out %d, ws %zu, need %zu)\n", n_in, n_in > 0 ? in_sizes[0] : -1, out_size, ws_size, (size_t)WS_END); grid = -1; return; }
        int dev = 0, cus = 0, per_cu = 0;
        if (hipGetDevice(&dev) != hipSuccess || hipDeviceGetAttribute(&cus, hipDeviceAttributeMultiprocessorCount, dev) != hipSuccess) { grid = -1; return; }
        if (hipFuncSetAttribute((const void*)mk_fwd, hipFuncAttributeMaxDynamicSharedMemorySize, LDS_BYTES) != hipSuccess) { fprintf(stderr, "kernel_launch: hipFuncSetAttribute failed\n"); grid = -1; return; }
        if (hipOccupancyMaxActiveBlocksPerMultiprocessor(&per_cu, (const void*)mk_fwd, 512, LDS_BYTES) != hipSuccess || per_cu < 1) fprintf(stderr, "kernel_launch: occupancy query reports %d\n", per_cu);
        (void)hipGetLastError();
        grid = cus < 256 ? cus : 256;
        if (grid != 256) fprintf(stderr, "kernel_launch: %d CUs; this kernel is laid out for 256\n", grid);
    }
    if (grid < 0) return;
    (void)hipMemsetAsync((char*)d_ws + WS_CTL, 0, CTL_ZERO_BYTES, stream);
    Args a{};
    for (int i = 0; i < 22; ++i) a.in[i] = (const float*)d_in[i];
    a.out = (float*)d_out; a.ws = (unsigned char*)d_ws;
    if (MK_N_LAUNCHES == 1) { a.ph_lo = 0; a.ph_hi = NPH; hipLaunchKernelGGL(mk_fwd, dim3(grid), dim3(512), LDS_BYTES, stream, a); }
    else {
#ifdef MK_DEBUG
        for (int pass = 0; pass < 2; ++pass) { a.pass = pass;
#else
        {
#endif
        for (int p = 0; p < NPH; ++p) { a.ph_lo = p; a.ph_hi = p + 1; hipLaunchKernelGGL(mk_fwd, dim3(grid), dim3(512), LDS_BYTES, stream, a);
#ifdef MK_DEBUG
            if (p < 12) { a.ph_lo = 100 + p; a.ph_hi = 101 + p; hipLaunchKernelGGL(mk_fwd, dim3(grid), dim3(512), LDS_BYTES, stream, a); }
#endif
        } }
    }
    const hipError_t le = hipPeekAtLastError();
    if (le != hipSuccess) fprintf(stderr, "kernel_launch: launch failed: %s\n", hipGetErrorName(le));
}
```

```cpp
#include <hip/hip_runtime.h>
#include <hip/hip_bf16.h>
#include <cstdio>
#include <cstdint>

#ifndef MK_N_LAUNCHES
#ifndef PEER_SYNC
#define PEER_SYNC 16
#endif
#ifndef UQ
#define UQ 2
#endif
#define MK_N_LAUNCHES 1
#endif

constexpr int NB = 4, SEQ = 4096, DM = 2048, LC = 256, LT = SEQ + LC  ;
constexpr int MT = NB * LT  , ML = NB * SEQ  , INW = 11776;
constexpr float EPS = 1e-6f;

#define LAS __attribute__((address_space(3)))
#define GAS __attribute__((address_space(1)))

namespace pg8 {
#define PG8_LAS __attribute__((address_space(3)))
typedef unsigned short bf16_t;
typedef short bf16x8 __attribute__((ext_vector_type(8)));
typedef float f32x4 __attribute__((ext_vector_type(4)));
typedef unsigned u32x4 __attribute__((ext_vector_type(4)));
typedef unsigned u32x2 __attribute__((ext_vector_type(2)));
typedef int i32x4 __attribute__((ext_vector_type(4)));
constexpr int BM = 256, BK = 64, HALF = 128, HTB = HALF * BK * 2, STAGE_BYTES = 8 * HTB, NXCD = 8, WGM = 8;

__host__ __device__ __forceinline__ int lds_byte(int r, int c) { const int st = (r >> 4) * 2 + (c >> 5), rr = r & 15, cc = c & 31, ob = rr * 64 + cc * 2; return st * 1024 + (ob ^ (((ob >> 9) & 1) << 5)); }
__host__ __device__ __forceinline__ void stage_rc(int b, int& R, int& C) { const int st = b / 1024, sb = b % 1024, swz = sb ^ (((sb >> 9) & 1) << 5); R = (st >> 1) * 16 + swz / 64; C = (st & 1) * 32 + (swz % 64) / 2; }
__host__ __device__ __forceinline__ int perm32(int rho) { const int n = rho >> 4, i = rho & 15; return 8 * (i >> 2) + 4 * n + (i & 3); }

struct Unit { int pm, pn; const char* a; const char* b; };
struct Gemm { int lda, ldb, K; const float* rs; float wsc; };

__device__ __forceinline__ bool static_tile(int nM, int nN, int G, int c, int i, int& pm, int& pn) {
    const int nwg = nM * nN; const long L = (long)i * G + c; if (L >= nwg) return false;
    int wgid = (int)L; { const int q = nwg / NXCD, r = nwg % NXCD, xcd = wgid % NXCD, off = wgid / NXCD; wgid = (xcd < r ? xcd * (q + 1) : r * (q + 1) + (xcd - r) * q) + off; }
    const int nig = WGM * nN, gid = wgid / nig, fm = gid * WGM, gsz = (nM - fm) < WGM ? (nM - fm) : WGM;
    pm = fm + ((wgid % nig) % gsz); pn = (wgid % nig) / gsz; return true;
}
struct PlainSched {
    int nM, nN, G, c; const char* A; const char* B; size_t ta, tb;
    __device__ __forceinline__ bool next(int i, Unit& u) const { int pm, pn; if (!static_tile(nM, nN, G, c, i, pm, pn)) return false; u.pm = pm; u.pn = pn; u.a = A + (size_t)pm * ta; u.b = B + (size_t)pn * tb; return true; }
};

typedef float f32x2c __attribute__((ext_vector_type(2))); typedef __bf16 bf16x2c __attribute__((ext_vector_type(2)));
__device__ __forceinline__ unsigned cvt_pk_bf16(float lo, float hi) { f32x2c v = {lo, hi}; bf16x2c b = __builtin_convertvector(v, bf16x2c); return __builtin_bit_cast(unsigned, b); }
__device__ __forceinline__ float bf_lo(unsigned w) { return __uint_as_float(w << 16); }
__device__ __forceinline__ float bf_hi(unsigned w) { return __uint_as_float(w & 0xffff0000u); }
__device__ __forceinline__ u32x4 pack8(f32x4 v0, f32x4 v1) { u32x4 w; w.x = cvt_pk_bf16(v0[0], v0[1]); w.y = cvt_pk_bf16(v0[2], v0[3]); w.z = cvt_pk_bf16(v1[0], v1[1]); w.w = cvt_pk_bf16(v1[2], v1[3]); return w; }
__device__ __forceinline__ float sigm(float v) { return __builtin_amdgcn_rcpf(1.0f + __expf(-v)); }
__device__ __forceinline__ unsigned q4_i8(f32x4 v) {
    const float MG = 12582912.f;
    const unsigned a = __float_as_uint(__builtin_amdgcn_fmed3f(v.x, -127.f, 127.f) + MG), b = __float_as_uint(__builtin_amdgcn_fmed3f(v.y, -127.f, 127.f) + MG);
    const unsigned c = __float_as_uint(__builtin_amdgcn_fmed3f(v.z, -127.f, 127.f) + MG), d = __float_as_uint(__builtin_amdgcn_fmed3f(v.w, -127.f, 127.f) + MG);
    return (a & 255u) | ((b & 255u) << 8) | ((c & 255u) << 16) | (d << 24);
}


struct EpiRoute {
    static constexpr bool PERM = true, AFTER_DRAIN = false;
    bf16_t *QA, *KA, *VA, *QR, *KR, *VR, *GR, *GA, *GT;
    const float* qnw_p; const float* knw_p;
    const float* cs;
    PG8_LAS float* xs;
    __device__ __forceinline__ void operator()(const f32x4 (&acc)[2][2][4][2], const Unit& u, int wr, int wc, int fr_, int fq_) const {
        int fr = fr_, fq = fq_; asm volatile("" : "+v"(fr), "+v"(fq));
        const int pn = u.pn, pm = u.pm, b = pm / 17, jt = pm % 17;
        const int rowAll = pm * 256, rowLat = (b * 16 + jt - 1) * 256;
        bf16_t* base; int ldc, row0, colt, kind = 0;
        if (pn < 4)       { base = QA; ldc = 1024; row0 = rowLat; colt = pn * 256; kind = 3; }
        else if (pn == 4) { base = KA; ldc = 256;  row0 = rowAll; colt = 0; kind = 3; }
        else if (pn == 5) { base = VA; ldc = 256;  row0 = rowAll; colt = 0; }
        else if (pn < 10) { base = QR; ldc = 1024; row0 = rowLat; colt = (pn - 6) * 256; kind = 4; }
        else if (pn < 14) { base = KR; ldc = 1024; row0 = rowAll; colt = (pn - 10) * 256; kind = jt ? 4 : 0; }
        else if (pn < 22) { base = VR; ldc = 2048; row0 = rowAll; colt = (pn - 14) * 256; }
        else if (pn < 30) { base = GR; ldc = 2048; row0 = rowLat; colt = (pn - 22) * 256; kind = 1; }
        else if (pn < 38) { base = GA; ldc = 2048; row0 = rowLat; colt = (pn - 30) * 256; kind = 2; }
        else              { base = GT; ldc = 2048; row0 = rowLat; colt = (pn - 38) * 256; kind = 2; }
        const int col0 = colt + wc * 32 + 8 * fq;
        if (kind < 3) {
#pragma unroll
            for (int ai = 0; ai < 2; ++ai)
#pragma unroll
                for (int m = 0; m < 4; ++m) { bf16_t* rowp = base + (size_t)(row0 + wr * 64 + fr + ai * HALF + m * 16) * ldc + col0;
#pragma unroll
                    for (int bj = 0; bj < 2; ++bj) { f32x4 v0 = acc[ai][bj][m][0], v1 = acc[ai][bj][m][1];
                        if (kind) {
#pragma unroll
                            for (int e = 0; e < 4; ++e) { const float s0 = sigm(v0[e]), s1 = sigm(v1[e]); v0[e] = kind == 1 ? v0[e] * s0 : s0; v1[e] = kind == 1 ? v1[e] * s1 : s1; } }
                        if (kind == 1 || (pn >= 10 && pn < 22)) {
                            int g0_ = __builtin_amdgcn_cvt_pk_fp8_f32(v0[0], v0[1], 0, false); g0_ = __builtin_amdgcn_cvt_pk_fp8_f32(v0[2], v0[3], g0_, true);
                            int g1_ = __builtin_amdgcn_cvt_pk_fp8_f32(v1[0], v1[1], 0, false); g1_ = __builtin_amdgcn_cvt_pk_fp8_f32(v1[2], v1[3], g1_, true);
                            *(u32x2*)((unsigned char*)base + (size_t)(row0 + wr * 64 + fr + ai * HALF + m * 16) * ldc + col0 + bj * HALF) = (u32x2){(unsigned)g0_, (unsigned)g1_}; }
                        else if (kind == 2) {
                            const float MG = 12582912.f; u32x2 w;
                            w.x = (__float_as_uint(v0[0] * 255.f + MG) & 255u) | ((__float_as_uint(v0[1] * 255.f + MG) & 255u) << 8) | ((__float_as_uint(v0[2] * 255.f + MG) & 255u) << 16) | (__float_as_uint(v0[3] * 255.f + MG) << 24);
                            w.y = (__float_as_uint(v1[0] * 255.f + MG) & 255u) | ((__float_as_uint(v1[1] * 255.f + MG) & 255u) << 8) | ((__float_as_uint(v1[2] * 255.f + MG) & 255u) << 16) | (__float_as_uint(v1[3] * 255.f + MG) << 24);
                            *(u32x2*)((unsigned char*)base + (size_t)(row0 + wr * 64 + fr + ai * HALF + m * 16) * ldc + col0 + bj * HALF) = w; }
                        else *(u32x4*)(rowp + bj * HALF) = pack8(v0, v1); } }
            return;
        }
        const bool rope = jt != 0; const int t0 = (jt - 1) * 256;
        const float sc = (pn >= 6 && pn < 10) ? 0.088388347648318440f : 1.0f;
        f32x4 w0 = {1.f, 1.f, 1.f, 1.f}, w1 = {1.f, 1.f, 1.f, 1.f};
        float invr[4];
#pragma unroll
        for (int k = 0; k < 4; ++k) invr[k] = exp2f(-(float)((16 * wc + 4 * fq + k) & 31) * (13.287712379549449f / 32.0f)) * 0.15915494309189535f;
        if (kind == 3) { const float* nw = (pn < 4 ? qnw_p : knw_p) + wc * 32 + 8 * fq; w0 = *(const f32x4*)nw; w1 = *(const f32x4*)(nw + 4);
#pragma unroll
            for (int ai = 0; ai < 2; ++ai)
#pragma unroll
                for (int m = 0; m < 4; ++m)
#pragma unroll
                    for (int bj = 0; bj < 2; ++bj) { const f32x4 v0 = acc[ai][bj][m][0], v1 = acc[ai][bj][m][1];
                        float s = ((v0[0] * v0[0] + v0[1] * v0[1]) + (v0[2] * v0[2] + v0[3] * v0[3])) + ((v1[0] * v1[0] + v1[1] * v1[1]) + (v1[2] * v1[2] + v1[3] * v1[3]));
                        s += __shfl_xor(s, 16); s += __shfl_xor(s, 32);
                        if (fq == 0) xs[(ai * HALF + wr * 64 + m * 16 + fr) * 8 + bj * 4 + wc] = s; }
            asm volatile("s_waitcnt lgkmcnt(0)" ::: "memory"); __builtin_amdgcn_s_barrier(); asm volatile("" ::: "memory");
        }
#pragma unroll
        for (int ai = 0; ai < 2; ++ai)
#pragma unroll
            for (int m = 0; m < 4; ++m) { const int r = ai * HALF + wr * 64 + m * 16 + fr; bf16_t* rowp = base + (size_t)(row0 + r) * ldc + col0;
                f32x4 ca = {1.f, 0.f, 1.f, 0.f}, cb = {1.f, 0.f, 1.f, 0.f};
                if (rope) { const int t = t0 + r; const float pos = (float)(wc < 2 ? (t >> 6) : (t & 63));
                    ca = (f32x4){__builtin_amdgcn_cosf(pos * invr[0]), __builtin_amdgcn_sinf(pos * invr[0]), __builtin_amdgcn_cosf(pos * invr[1]), __builtin_amdgcn_sinf(pos * invr[1])};
                    cb = (f32x4){__builtin_amdgcn_cosf(pos * invr[2]), __builtin_amdgcn_sinf(pos * invr[2]), __builtin_amdgcn_cosf(pos * invr[3]), __builtin_amdgcn_sinf(pos * invr[3])}; }
#pragma unroll
                for (int bj = 0; bj < 2; ++bj) { f32x4 v0 = acc[ai][bj][m][0] * w0, v1 = acc[ai][bj][m][1] * w1; float rs = sc;
                    if (kind == 3) { const f32x4 pt = *(const PG8_LAS f32x4*)(xs + r * 8 + bj * 4); rs = rsqrtf(((pt[0] + pt[1]) + (pt[2] + pt[3])) * (1.f / 128.f) + 1e-6f); }
                    const f32x4 o0 = {v0[0] * ca[0] - v0[1] * ca[1], v0[1] * ca[0] + v0[0] * ca[1], v0[2] * ca[2] - v0[3] * ca[3], v0[3] * ca[2] + v0[2] * ca[3]};
                    const f32x4 o1 = {v1[0] * cb[0] - v1[1] * cb[1], v1[1] * cb[0] + v1[0] * cb[1], v1[2] * cb[2] - v1[3] * cb[3], v1[3] * cb[2] + v1[2] * cb[3]};
                    if (kind == 3 || kind == 4) {
                        const f32x4 a0 = o0 * rs, a1 = o1 * rs; u32x2 w8;
                        int p0_ = __builtin_amdgcn_cvt_pk_fp8_f32(a0[0], a0[1], 0, false); p0_ = __builtin_amdgcn_cvt_pk_fp8_f32(a0[2], a0[3], p0_, true);
                        int p1_ = __builtin_amdgcn_cvt_pk_fp8_f32(a1[0], a1[1], 0, false); p1_ = __builtin_amdgcn_cvt_pk_fp8_f32(a1[2], a1[3], p1_, true);
                        w8.x = (unsigned)p0_; w8.y = (unsigned)p1_;
                        *(u32x2*)((unsigned char*)base + (size_t)(row0 + r) * ldc + col0 + bj * HALF) = w8; }
                    else *(u32x4*)(rowp + bj * HALF) = pack8(o0 * rs, o1 * rs); } }
    }
};
template <int MODE> struct EpiB {
    static constexpr bool PERM = true, AFTER_DRAIN = false;
    bf16_t* O; int ldc; const bf16_t* Gm; const bf16_t* Tm;
    __device__ __forceinline__ void operator()(const f32x4 (&acc)[2][2][4][2], const Unit& u, int wr, int wc, int fr, int fq) const {
        const int row0 = u.pm * BM + wr * 64 + fr, col0 = u.pn * BM + wc * 32 + 8 * fq;
#pragma unroll
        for (int ai = 0; ai < 2; ++ai)
#pragma unroll
            for (int m = 0; m < 4; ++m) { const size_t off = (size_t)(row0 + ai * HALF + m * 16) * ldc + col0;
#pragma unroll
                for (int bj = 0; bj < 2; ++bj) { f32x4 v0 = acc[ai][bj][m][0], v1 = acc[ai][bj][m][1];
                    if (MODE >= 1) { const u32x2 g = *(const u32x2*)((const unsigned char*)Gm + off + bj * HALF);
#pragma unroll
                        for (int e = 0; e < 4; ++e) { v0[e] *= (float)((g.x >> (8 * e)) & 255u) * (1.f / 255.f); v1[e] *= (float)((g.y >> (8 * e)) & 255u) * (1.f / 255.f); } }
                    if (MODE == 2) { const u32x4 t = *(const u32x4*)(Tm + off + bj * HALF);
                        v0[0] += bf_lo(t.x); v0[1] += bf_hi(t.x); v0[2] += bf_lo(t.y); v0[3] += bf_hi(t.y); v1[0] += bf_lo(t.z); v1[1] += bf_hi(t.z); v1[2] += bf_lo(t.w); v1[3] += bf_hi(t.w); }
                    *(u32x4*)(O + off + bj * HALF) = pack8(v0, v1); } }
    }
};
struct EpiX {
    static constexpr bool PERM = true, AFTER_DRAIN = false;
    bf16_t* O; const float* X; const float* mod;
    __device__ __forceinline__ void operator()(const f32x4 (&acc)[2][2][4][2], const Unit& u, int wr, int wc, int fr, int fq) const {
        const int row0 = u.pm * BM + wr * 64 + fr, col0 = u.pn * BM + wc * 32 + 8 * fq;
        const float* mp = mod + (size_t)((u.pm * BM) / SEQ) * 12288 + col0;
        f32x4 mv[2][2];
#pragma unroll
        for (int bj = 0; bj < 2; ++bj) { mv[bj][0] = *(const f32x4*)(mp + bj * HALF); mv[bj][1] = *(const f32x4*)(mp + bj * HALF + 4); }
#pragma unroll
        for (int ai = 0; ai < 2; ++ai)
#pragma unroll
            for (int m = 0; m < 4; ++m) { const size_t off = (size_t)(row0 + ai * HALF + m * 16) * 2048 + col0;
#pragma unroll
                for (int bj = 0; bj < 2; ++bj) { const f32x4 x0 = *(const f32x4*)(X + off + bj * HALF), x1 = *(const f32x4*)(X + off + bj * HALF + 4);
                    *(u32x4*)(O + off + bj * HALF) = pack8(x0 + mv[bj][0] * acc[ai][bj][m][0], x1 + mv[bj][1] * acc[ai][bj][m][1]); } }
    }
};
typedef _Float16 f16x2c __attribute__((ext_vector_type(2)));
__device__ __forceinline__ unsigned cvt_pk_f16(float lo, float hi) { f32x2c v = {lo, hi}; return __builtin_bit_cast(unsigned, __builtin_convertvector(v, f16x2c)); }
struct EpiH {
    static constexpr bool PERM = true, AFTER_DRAIN = false;
    _Float16* C; int ldc; const float* cs;
    __device__ __forceinline__ void operator()(const f32x4 (&acc)[2][2][4][2], const Unit& u, int wr, int wc, int fr, int fq) const {
        const int row0 = u.pm * BM + wr * 64 + fr, col0 = u.pn * BM + wc * 32 + 8 * fq;
        f32x4 cv[2][2];
#pragma unroll
        for (int bj = 0; bj < 2; ++bj) { cv[bj][0] = *(const f32x4*)(cs + col0 + bj * HALF); cv[bj][1] = *(const f32x4*)(cs + col0 + bj * HALF + 4); }
#pragma unroll
        for (int ai = 0; ai < 2; ++ai)
#pragma unroll
            for (int m = 0; m < 4; ++m) { const size_t off = (size_t)(row0 + ai * HALF + m * 16) * ldc + col0;
#pragma unroll
                for (int bj = 0; bj < 2; ++bj) { const f32x4 v0 = acc[ai][bj][m][0] * cv[bj][0], v1 = acc[ai][bj][m][1] * cv[bj][1];
                    u32x4 w; w.x = cvt_pk_f16(v0[0], v0[1]); w.y = cvt_pk_f16(v0[2], v0[3]); w.z = cvt_pk_f16(v1[0], v1[1]); w.w = cvt_pk_f16(v1[2], v1[3]);
                    *(u32x4*)(C + off + bj * HALF) = w; } }
    }
};
struct EpiTQ {
    static constexpr bool PERM = true, AFTER_DRAIN = false;
    unsigned char* O; const unsigned char* Gm; const float* qst;
    __device__ __forceinline__ void operator()(const f32x4 (&acc)[2][2][4][2], const Unit& u, int wr, int wc, int fr, int fq) const {
        const int row0 = u.pm * BM + wr * 64 + fr, col0 = u.pn * BM + wc * 32 + 8 * fq;
#pragma unroll
        for (int ai = 0; ai < 2; ++ai)
#pragma unroll
            for (int m = 0; m < 4; ++m) { const int row = row0 + ai * HALF + m * 16; const size_t off = (size_t)row * 2048 + col0; const float qs = qst[row] * (1.f / 255.f);
#pragma unroll
                for (int bj = 0; bj < 2; ++bj) { f32x4 v0 = acc[ai][bj][m][0], v1 = acc[ai][bj][m][1];
                    const u32x2 g = *(const u32x2*)(Gm + off + bj * HALF);
#pragma unroll
                    for (int e = 0; e < 4; ++e) { v0[e] *= (float)((g.x >> (8 * e)) & 255u); v1[e] *= (float)((g.y >> (8 * e)) & 255u); }
                    u32x2 w; w.x = q4_i8(v0 * qs); w.y = q4_i8(v1 * qs); *(u32x2*)(O + off + bj * HALF) = w; } }
    }
};
struct EpiMixQ {
    static constexpr bool PERM = true, AFTER_DRAIN = false;
    unsigned char* O; const unsigned char* Gm; const unsigned char* Tm; const float* qsm; const float* rst;
    __device__ __forceinline__ void operator()(const f32x4 (&acc)[2][2][4][2], const Unit& u, int wr, int wc, int fr, int fq) const {
        const int row0 = u.pm * BM + wr * 64 + fr, col0 = u.pn * BM + wc * 32 + 8 * fq;
#pragma unroll
        for (int ai = 0; ai < 2; ++ai)
#pragma unroll
            for (int m = 0; m < 4; ++m) { const int row = row0 + ai * HALF + m * 16; const size_t off = (size_t)row * 2048 + col0; const float qs = qsm[row], rt = rst[row];
#pragma unroll
                for (int bj = 0; bj < 2; ++bj) { f32x4 v0 = acc[ai][bj][m][0], v1 = acc[ai][bj][m][1];
                    const u32x2 g = *(const u32x2*)(Gm + off + bj * HALF); const u32x2 t = *(const u32x2*)(Tm + off + bj * HALF);
#pragma unroll
                    for (int e = 0; e < 4; ++e) { v0[e] *= (float)((g.x >> (8 * e)) & 255u) * (1.f / 255.f); v1[e] *= (float)((g.y >> (8 * e)) & 255u) * (1.f / 255.f); }
#pragma unroll
                    for (int e = 0; e < 3; ++e) { v0[e] += (float)(int)(signed char)((t.x >> (8 * e)) & 255u) * rt; v1[e] += (float)(int)(signed char)((t.y >> (8 * e)) & 255u) * rt; }
                    v0[3] += (float)((int)t.x >> 24) * rt; v1[3] += (float)((int)t.y >> 24) * rt;
                    u32x2 w; w.x = q4_i8(v0 * qs); w.y = q4_i8(v1 * qs); *(u32x2*)(O + off + bj * HALF) = w; } }
    }
};
template <int MODE> struct EpiF {
    static constexpr bool PERM = false, AFTER_DRAIN = false;
    float* C; int ldc; const float* X; const float* mod;
    __device__ __forceinline__ void operator()(const f32x4 (&acc)[2][2][4][2], const Unit& u, int wr, int wc, int fr, int fq) const {
        const int row0 = u.pm * BM + wr * 64 + fr, col0 = u.pn * BM + wc * 32 + 4 * fq;
        f32x4 mv[2][2];
        if (MODE == 1) { const float* mp = mod + (size_t)((u.pm * BM) / SEQ) * 12288 + col0;
#pragma unroll
            for (int bj = 0; bj < 2; ++bj)
#pragma unroll
                for (int n = 0; n < 2; ++n) mv[bj][n] = *(const f32x4*)(mp + bj * HALF + n * 16); }
#pragma unroll
        for (int ai = 0; ai < 2; ++ai)
#pragma unroll
            for (int m = 0; m < 4; ++m) { const size_t off = (size_t)(row0 + ai * HALF + m * 16) * ldc + col0;
#pragma unroll
                for (int bj = 0; bj < 2; ++bj)
#pragma unroll
                    for (int n = 0; n < 2; ++n) { f32x4 v = acc[ai][bj][m][n];
                        if (MODE == 1) v = *(const f32x4*)(X + off + bj * HALF + n * 16) + mv[bj][n] * v;
                        *(f32x4*)(C + off + bj * HALF + n * 16) = v; } }
    }
};

template <class Epi, class Sched, bool ALIGN_EPI = true, bool SP2 = true, bool I8 = false>
__device__ __forceinline__ void gemm_phase(PG8_LAS unsigned char* lds, const Gemm g, const Sched& S, const Epi& E) {
    const int tid = threadIdx.x, wid = __builtin_amdgcn_readfirstlane(tid >> 6), lane = tid & 63, wr = wid >> 2, wc = wid & 3, fr = lane & 15, fq = lane >> 4;
    const int K = g.K, nt = K / BK;
    unsigned voffA[2], voffB[2];
#pragma unroll
    for (int i = 0; i < 2; ++i) { int R, C; stage_rc(tid * 16 + i * 8192, R, C); const int Rb = Epi::PERM ? ((R & ~31) + perm32(R & 31)) : R;
        voffA[i] = (unsigned)(R * g.lda + C) * 2u; voffB[i] = (unsigned)(Rb * g.ldb + C) * 2u; }
    const size_t kstep = (size_t)(BK * 2);
    const size_t hstepA = (size_t)HALF * g.lda * 2, hstepB = (size_t)HALF * g.ldb * 2;
    const unsigned ldsw = (unsigned)wid * 1024u;
    const int aoff = lds_byte(wr * 64 + fr, fq * 8), boff = lds_byte(wc * 32 + fr, fq * 8);
#define PG8_SA(b, h) (((b) * 2 + (h)) * HTB)
#define PG8_SB(b, h) ((4 + (b) * 2 + (h)) * HTB)
#define PG8_STAGE(bufoff, gbase, voff) do { _Pragma("unroll") for (int _i = 0; _i < 2; ++_i) \
        __builtin_amdgcn_global_load_lds((const unsigned*)((const char*)(gbase) + (voff)[_i]), (PG8_LAS unsigned*)(lds + (bufoff) + ldsw + _i * 8192), 16, 0, 0); } while (0)
#define PG8_LDA(dst, b, h) do { _Pragma("unroll") for (int m = 0; m < 4; ++m) _Pragma("unroll") for (int k = 0; k < 2; ++k) dst[m][k] = *(const PG8_LAS bf16x8*)(lds + PG8_SA(b, h) + aoff + m * 2048 + k * 1024); } while (0)
#define PG8_LDB(dst, b, h) do { _Pragma("unroll") for (int n = 0; n < 2; ++n) _Pragma("unroll") for (int k = 0; k < 2; ++k) dst[n][k] = *(const PG8_LAS bf16x8*)(lds + PG8_SB(b, h) + boff + n * 2048 + k * 1024); } while (0)
#define PG8_MMA(ai, bj, At, Bt) do { __builtin_amdgcn_s_setprio(1); _Pragma("unroll") for (int m = 0; m < 4; ++m) _Pragma("unroll") for (int n = 0; n < 2; ++n) _Pragma("unroll") for (int k = 0; k < 2; ++k) { \
        if constexpr (I8) acc[ai][bj][m][n] = __builtin_bit_cast(f32x4, __builtin_amdgcn_mfma_i32_16x16x64_i8(__builtin_bit_cast(i32x4, Bt[n][k]), __builtin_bit_cast(i32x4, At[m][k]), __builtin_bit_cast(i32x4, acc[ai][bj][m][n]), 0, 0, 0)); \
        else acc[ai][bj][m][n] = __builtin_amdgcn_mfma_f32_16x16x32_bf16(Bt[n][k], At[m][k], acc[ai][bj][m][n], 0, 0, 0); } \
        __builtin_amdgcn_s_setprio(0); } while (0)
#define PG8_WAIT_V(n) asm volatile("s_waitcnt vmcnt(" #n ")" ::: "memory")
#define PG8_WAIT_L(n) asm volatile("s_waitcnt lgkmcnt(" #n ")" ::: "memory")
#define PG8_BAR __builtin_amdgcn_s_barrier()
#define PG8_SCHED __builtin_amdgcn_sched_barrier(0)
    Unit cur, nxt; int ui = 0;
    if (!S.next(0, cur)) return;
    f32x4 acc[2][2][4][2];
#pragma unroll
    for (int a = 0; a < 2; ++a)
#pragma unroll
        for (int b = 0; b < 2; ++b)
#pragma unroll
            for (int m = 0; m < 4; ++m)
#pragma unroll
                for (int n = 0; n < 2; ++n) acc[a][b][m][n] = (f32x4){0.f, 0.f, 0.f, 0.f};
    bf16x8 At[4][2], B0[2][2], B1[2][2];
    const char* cA = cur.a; const char* cB = cur.b;
    if constexpr (SP2) {
        PG8_STAGE(PG8_SB(0, 0), cB, voffB); PG8_STAGE(PG8_SB(0, 1), cB + hstepB, voffB); PG8_STAGE(PG8_SA(0, 0), cA, voffA); PG8_STAGE(PG8_SA(0, 1), cA + hstepA, voffA);
        if (wr == 1) PG8_BAR;
        PG8_WAIT_V(2); PG8_BAR;
        PG8_STAGE(PG8_SB(1, 0), cB + kstep, voffB); PG8_STAGE(PG8_SA(1, 0), cA + kstep, voffA); PG8_STAGE(PG8_SB(1, 1), cB + hstepB + kstep, voffB);
        PG8_WAIT_V(6); PG8_BAR;
    } else {
        PG8_STAGE(PG8_SB(0, 0), cB, voffB); PG8_STAGE(PG8_SA(0, 0), cA, voffA); PG8_STAGE(PG8_SB(0, 1), cB + hstepB, voffB); PG8_STAGE(PG8_SA(0, 1), cA + hstepA, voffA);
        if (wr == 1) PG8_BAR;
        PG8_WAIT_V(4); PG8_BAR;
        PG8_STAGE(PG8_SB(1, 0), cB + kstep, voffB); PG8_STAGE(PG8_SA(1, 0), cA + kstep, voffA); PG8_STAGE(PG8_SB(1, 1), cB + hstepB + kstep, voffB);
        PG8_WAIT_V(6); PG8_BAR;
    }
    for (;;) {
        const bool has_next = S.next(ui + 1, nxt);
        const char* nA = has_next ? nxt.a : cA; const char* nB = has_next ? nxt.b : cB;
        for (int t = 0; t < nt; t += 2) {
            const bool last = (t == nt - 2);
            const char* a1 = cA + (size_t)(t + 1) * kstep;
            const char* a2 = last ? nA : cA + (size_t)(t + 2) * kstep; const char* b2 = last ? nB : cB + (size_t)(t + 2) * kstep;
            const char* a3 = a2 + kstep; const char* b3 = b2 + kstep;
            if constexpr (SP2) {
            PG8_LDB(B0, 0, 0); PG8_LDB(B1, 0, 1); PG8_SCHED; PG8_LDA(At, 0, 0); PG8_STAGE(PG8_SA(1, 1), a1 + hstepA, voffA);
            PG8_WAIT_V(8); PG8_WAIT_L(0); PG8_BAR; PG8_MMA(0, 0, At, B0); PG8_MMA(0, 1, At, B1); PG8_BAR; PG8_SCHED;
            PG8_LDA(At, 0, 1); PG8_STAGE(PG8_SB(0, 0), b2, voffB); PG8_STAGE(PG8_SB(0, 1), b2 + hstepB, voffB); PG8_STAGE(PG8_SA(0, 0), a2, voffA);
            PG8_WAIT_V(8); PG8_WAIT_L(0); PG8_BAR; PG8_MMA(1, 0, At, B0); PG8_MMA(1, 1, At, B1); PG8_BAR; PG8_SCHED;
            PG8_LDB(B0, 1, 0); PG8_LDB(B1, 1, 1); PG8_SCHED; PG8_LDA(At, 1, 0); PG8_STAGE(PG8_SA(0, 1), a2 + hstepA, voffA);
            PG8_WAIT_V(8); PG8_WAIT_L(0); PG8_BAR; PG8_MMA(0, 0, At, B0); PG8_MMA(0, 1, At, B1); PG8_BAR; PG8_SCHED;
            PG8_LDA(At, 1, 1); PG8_STAGE(PG8_SB(1, 0), b3, voffB); PG8_STAGE(PG8_SB(1, 1), b3 + hstepB, voffB); PG8_STAGE(PG8_SA(1, 0), a3, voffA);
            PG8_WAIT_V(8); PG8_WAIT_L(0); PG8_BAR; PG8_MMA(1, 0, At, B0); PG8_MMA(1, 1, At, B1); PG8_BAR; PG8_SCHED;
            } else {
            PG8_LDB(B0, 0, 0); PG8_SCHED; PG8_LDA(At, 0, 0); PG8_STAGE(PG8_SA(1, 1), a1 + hstepA, voffA);
            PG8_WAIT_L(8); PG8_BAR; PG8_WAIT_L(0); PG8_MMA(0, 0, At, B0); PG8_BAR; PG8_SCHED;
            PG8_LDB(B1, 0, 1); PG8_STAGE(PG8_SB(0, 0), b2, voffB);
            PG8_BAR; PG8_WAIT_L(0); PG8_MMA(0, 1, At, B1); PG8_BAR;
            PG8_LDA(At, 0, 1); PG8_STAGE(PG8_SA(0, 0), a2, voffA);
            PG8_BAR; PG8_WAIT_L(0); PG8_MMA(1, 0, At, B0); PG8_BAR; PG8_SCHED;
            PG8_STAGE(PG8_SB(0, 1), b2 + hstepB, voffB);
            PG8_WAIT_V(6); PG8_BAR; PG8_MMA(1, 1, At, B1); PG8_BAR;
            PG8_LDB(B0, 1, 0); PG8_SCHED; PG8_LDA(At, 1, 0); PG8_STAGE(PG8_SA(0, 1), a2 + hstepA, voffA);
            PG8_WAIT_L(8); PG8_BAR; PG8_WAIT_L(0); PG8_MMA(0, 0, At, B0); PG8_BAR; PG8_SCHED;
            PG8_LDB(B1, 1, 1); PG8_STAGE(PG8_SB(1, 0), b3, voffB);
            PG8_BAR; PG8_WAIT_L(0); PG8_MMA(0, 1, At, B1); PG8_BAR;
            PG8_LDA(At, 1, 1); PG8_STAGE(PG8_SA(1, 0), a3, voffA);
            PG8_BAR; PG8_WAIT_L(0); PG8_MMA(1, 0, At, B0); PG8_BAR; PG8_SCHED;
            PG8_STAGE(PG8_SB(1, 1), b3 + hstepB, voffB);
            PG8_WAIT_V(6); PG8_BAR; PG8_MMA(1, 1, At, B1); PG8_BAR;
            }
        }
        float dsc[8];
        if constexpr (I8) {
#pragma unroll
            for (int a = 0; a < 2; ++a)
#pragma unroll
                for (int m = 0; m < 4; ++m) dsc[a * 4 + m] = g.rs[cur.pm * BM + a * HALF + wr * 64 + m * 16 + fr]; }
        if constexpr (ALIGN_EPI) { if (wr == 0) PG8_BAR; }
        if constexpr (I8) {
#pragma unroll
            for (int a = 0; a < 2; ++a)
#pragma unroll
                for (int m = 0; m < 4; ++m) { const float d = dsc[a * 4 + m] * g.wsc;
#pragma unroll
                    for (int b = 0; b < 2; ++b)
#pragma unroll
                        for (int n = 0; n < 2; ++n) acc[a][b][m][n] = __builtin_convertvector(__builtin_bit_cast(i32x4, acc[a][b][m][n]), f32x4) * d; } }
        E(acc, cur, wr, wc, fr, fq);
        if (!has_next) break;
#pragma unroll
        for (int a = 0; a < 2; ++a)
#pragma unroll
            for (int b = 0; b < 2; ++b)
#pragma unroll
                for (int m = 0; m < 4; ++m)
#pragma unroll
                    for (int n = 0; n < 2; ++n) acc[a][b][m][n] = (f32x4){0.f, 0.f, 0.f, 0.f};
        cur = nxt; cA = nA; cB = nB; ++ui;
        if constexpr (ALIGN_EPI) { if (wr == 1) PG8_BAR; }
    }
    PG8_WAIT_V(0);
    if constexpr (!ALIGN_EPI) { if (wr == 0) PG8_BAR; }
    PG8_BAR;
#undef PG8_SA
#undef PG8_SB
#undef PG8_STAGE
#undef PG8_LDA
#undef PG8_LDB
#undef PG8_MMA
#undef PG8_WAIT_V
#undef PG8_WAIT_L
#undef PG8_BAR
#undef PG8_SCHED
}
}

typedef unsigned short bf16_t;
typedef short bf16x8 __attribute__((ext_vector_type(8)));
typedef short s16x4 __attribute__((ext_vector_type(4)));
typedef float f32x4 __attribute__((ext_vector_type(4)));
typedef float f32x16 __attribute__((ext_vector_type(16)));
typedef float f32x2 __attribute__((ext_vector_type(2)));
typedef unsigned u32x4 __attribute__((ext_vector_type(4)));
typedef unsigned u32x2 __attribute__((ext_vector_type(2)));
typedef __bf16 bf16x2_t __attribute__((ext_vector_type(2)));
using pg8::cvt_pk_bf16; using pg8::bf_lo; using pg8::bf_hi; using pg8::sigm; using pg8::q4_i8;
typedef float f32x16 __attribute__((ext_vector_type(16))); typedef float f32x32 __attribute__((ext_vector_type(32)));
typedef unsigned u32x6 __attribute__((ext_vector_type(6))); typedef int i32x8 __attribute__((ext_vector_type(8)));
__device__ __forceinline__ u32x6 pack_fp6(const f32x4 (&v)[8], float sc) {
    f32x16 a, b;
#pragma unroll
    for (int i = 0; i < 4; ++i)
#pragma unroll
        for (int e = 0; e < 2; ++e) {
            a[4 * i + e] = v[2 * i][2 * e] * sc; b[4 * i + e] = v[2 * i][2 * e + 1] * sc; a[4 * i + 2 + e] = v[2 * i + 1][2 * e] * sc; b[4 * i + 2 + e] = v[2 * i + 1][2 * e + 1] * sc; }
    return __builtin_amdgcn_cvt_scalef32_2xpk16_fp6_f32(a, b, 1.0f);
}
constexpr float PEER_SU = 80.f, PEER_SV = 1.75f;
constexpr float QW_2048 = 127.f / (6.5f * 0.02209708691f), QW_1024 = 127.f / (6.5f * 0.03125f);

namespace att {
constexpr int D = 128, NW = 8, QBLK = 32, KVBLK = 64;
constexpr float SCALE = 0.088388347648318440f;
constexpr float THR = 8.f;
constexpr int LDQ = 1024, LDK = 256, LDO = 1024;
constexpr size_t SHM_V = KVBLK * D * 2, SHM_K = KVBLK * D  , SHM_ATTN = 2 * SHM_V + 2 * SHM_K + NW * 64 * 4;
#define KSWZ8(row, ch) ((row) * 128 + ((((ch) ^ (((row) >> 1) & 15))) << 3))
#define KSWZ(row, colB) ((row) * 256 + ((colB) ^ (((row) & 7) << 4)))
#define SBAR() __builtin_amdgcn_sched_barrier(0)
__device__ __forceinline__ int crow(int r, int hi) { return (r & 3) + 8 * (r >> 2) + 4 * hi; }
__device__ __forceinline__ unsigned cvtpk(float lo, float hi) { unsigned r; asm volatile("v_cvt_pk_bf16_f32 %0, %1, %2" : "=v"(r) : "v"(lo), "v"(hi)); return r; }
template <bool FIXED>
__device__ __forceinline__ void partialSM(f32x16& p0, f32x16& p1, float& m_reg, float& mn, float& alpha) {
  constexpr float C = SCALE * 1.4426950408889634f;
  if constexpr (FIXED) { mn = m_reg; alpha = 1.f; const float mnC_ = -m_reg * C;
    for (int r = 0; r < 16; ++r) p0[r] = fmaf(p0[r], C, mnC_); for (int r = 0; r < 16; ++r) p1[r] = fmaf(p1[r], C, mnC_);
    for (int r = 0; r < 16; ++r) p0[r] = __builtin_amdgcn_exp2f(p0[r]);
    return; }
  float pmax = p0[0]; for (int r = 1; r < 16; ++r) pmax = fmaxf(pmax, p0[r]); for (int r = 0; r < 16; ++r) pmax = fmaxf(pmax, p1[r]);
  { auto rr = __builtin_amdgcn_permlane32_swap(__float_as_uint(pmax), __float_as_uint(pmax), false, false);
    pmax = fmaxf(__uint_as_float(rr[0]), __uint_as_float(rr[1])); }
  if (__builtin_expect(__all(pmax - m_reg <= THR / SCALE), 1)) { mn = m_reg; alpha = 1.f; }
  else { mn = fmaxf(m_reg, pmax); alpha = __builtin_amdgcn_exp2f((m_reg - mn) * C); m_reg = mn; }
  float mnC = -mn * C;
  for (int r = 0; r < 16; ++r) p0[r] = fmaf(p0[r], C, mnC); for (int r = 0; r < 16; ++r) p1[r] = fmaf(p1[r], C, mnC);
  for (int r = 0; r < 16; ++r) p0[r] = __builtin_amdgcn_exp2f(p0[r]);
}
__device__ __forceinline__ void finishSM(f32x16& p0, f32x16& p1, float alpha, float& l_reg, bf16x8& pa0, bf16x8& pa1, bf16x8& pa2, bf16x8& pa3) {
  for (int r = 0; r < 16; ++r) p1[r] = __builtin_amdgcn_exp2f(p1[r]);
  float ps = 0; for (int r = 0; r < 16; ++r) ps += p0[r]; for (int r = 0; r < 16; ++r) ps += p1[r];
  { auto rr = __builtin_amdgcn_permlane32_swap(__float_as_uint(ps), __float_as_uint(ps), false, false);
    ps = __uint_as_float(rr[0]) + __uint_as_float(rr[1]); }
  l_reg = l_reg * alpha + ps;
#define PK4(P, BASE, OUT) do { unsigned a0 = cvtpk(P[BASE + 0], P[BASE + 1]), a1 = cvtpk(P[BASE + 2], P[BASE + 3]);   \
    unsigned b0 = cvtpk(P[BASE + 4], P[BASE + 5]), b1 = cvtpk(P[BASE + 6], P[BASE + 7]);                              \
    auto r0 = __builtin_amdgcn_permlane32_swap(a0, b0, false, false); auto r1 = __builtin_amdgcn_permlane32_swap(a1, b1, false, false); \
    u32x4 w = {r0[0], r1[0], r0[1], r1[1]}; OUT = *reinterpret_cast<bf16x8*>(&w); } while (0)
  PK4(p0, 0, pa0); PK4(p0, 8, pa1); PK4(p1, 0, pa2); PK4(p1, 8, pa3);
#undef PK4
}
__device__ __forceinline__ void qkt(f32x16& p0, f32x16& p1, const unsigned char* Ks, const long* qr, int r32, int hi) {
  p0 = f32x16{}; p1 = f32x16{};
  long b0 = *reinterpret_cast<const long*>(Ks + KSWZ8(r32, hi)), b1 = *reinterpret_cast<const long*>(Ks + KSWZ8(32 + r32, hi));
#pragma unroll
  for (int d0 = 0; d0 < 8; ++d0) { long n0 = 0, n1 = 0;
    if (d0 < 7) { const int ch = (d0 + 1) * 2 + hi; n0 = *reinterpret_cast<const long*>(Ks + KSWZ8(r32, ch)); n1 = *reinterpret_cast<const long*>(Ks + KSWZ8(32 + r32, ch)); }
    __builtin_amdgcn_sched_group_barrier(0x100, 2, 0);
    p0 = __builtin_amdgcn_mfma_f32_32x32x16_fp8_fp8(b0, qr[d0], p0, 0, 0, 0);
    p1 = __builtin_amdgcn_mfma_f32_32x32x16_fp8_fp8(b1, qr[d0], p1, 0, 0, 0);
    __builtin_amdgcn_sched_group_barrier(0x008, 2, 0);
    b0 = n0; b1 = n1; }
}
__device__ __forceinline__ int v_st(int k, int c) { const int kk = (k & ~0xC) | ((k & 4) << 1) | ((k & 8) >> 1); return ((kk >> 3) * 4 + (c >> 5)) * 512 + ((kk & 7) * 32 + (c & 31)) * 2; }
__device__ __forceinline__ int v_rd_base(int lane) { return ((lane & 3) << 3) | (((lane >> 2) & 3) << 6) | (((lane >> 4) & 1) << 5) | (((lane >> 5) & 1) << 8); }
constexpr int v_rd_off(int d0, int ks, int half) { return d0 * 512 + ks * 4096 + half * 2048; }
template <int OFF> __device__ __forceinline__ s16x4 tr_read(int vb) {
  s16x4 r; asm volatile("ds_read_b64_tr_b16 %0, %1 offset:%2" : "=&v"(r) : "v"(vb), "i"(OFF) : "memory"); return r;
}
template <int D0> __device__ __forceinline__ void pv_one(f32x16& od, int vb, bf16x8 pa0, bf16x8 pa1, bf16x8 pa2, bf16x8 pa3) {
  const s16x4 l0 = tr_read<v_rd_off(D0, 0, 0)>(vb), h0 = tr_read<v_rd_off(D0, 0, 1)>(vb), l1 = tr_read<v_rd_off(D0, 1, 0)>(vb), h1 = tr_read<v_rd_off(D0, 1, 1)>(vb);
  const s16x4 l2 = tr_read<v_rd_off(D0, 2, 0)>(vb), h2 = tr_read<v_rd_off(D0, 2, 1)>(vb), l3 = tr_read<v_rd_off(D0, 3, 0)>(vb), h3 = tr_read<v_rd_off(D0, 3, 1)>(vb);
  asm volatile("s_waitcnt lgkmcnt(0)" ::: "memory"); SBAR();
#define PK(L, H) (bf16x8){L[0], L[1], L[2], L[3], H[0], H[1], H[2], H[3]}
  od = __builtin_amdgcn_mfma_f32_32x32x16_bf16(pa0, PK(l0, h0), od, 0, 0, 0);
  od = __builtin_amdgcn_mfma_f32_32x32x16_bf16(pa1, PK(l1, h1), od, 0, 0, 0);
  od = __builtin_amdgcn_mfma_f32_32x32x16_bf16(pa2, PK(l2, h2), od, 0, 0, 0);
  od = __builtin_amdgcn_mfma_f32_32x32x16_bf16(pa3, PK(l3, h3), od, 0, 0, 0);
#undef PK
}
__device__ __forceinline__ void pv_d0(f32x16* o, int vb, bf16x8 pa0, bf16x8 pa1, bf16x8 pa2, bf16x8 pa3) {
  pv_one<0>(o[0], vb, pa0, pa1, pa2, pa3); pv_one<1>(o[1], vb, pa0, pa1, pa2, pa3); pv_one<2>(o[2], vb, pa0, pa1, pa2, pa3); pv_one<3>(o[3], vb, pa0, pa1, pa2, pa3);
}
template <bool FIXED>
__device__ __forceinline__ void attn_dense_body(const unsigned char* __restrict__ Qb  , const unsigned char* __restrict__ Kh  , const bf16_t* __restrict__ Vh,
                                                bf16_t* __restrict__ Ob, int seq, char* lds, float mfix) {
  int tid_ = threadIdx.x; asm volatile("" : "+v"(tid_));
  const int tid = tid_, wid = __builtin_amdgcn_readfirstlane(tid >> 6), lane = tid & 63, r32 = lane & 31, hi = lane >> 5;
  bf16_t* V_lds = (bf16_t*)lds; unsigned char* K_lds = (unsigned char*)(lds + 2 * SHM_V);
  float* ws = (float*)(lds + 2 * SHM_V + 2 * SHM_K) + wid * 64; float* li_l = ws; float* al_l = ws + 32;
  float m_reg = FIXED ? mfix : -1e30f, l_reg = 0; f32x16 o[4] = {}; long qr[8];
  const GAS unsigned char* Qw = (const GAS unsigned char*)(unsigned long long)(Qb + (long)(wid * QBLK + r32) * LDQ + hi * 8);
  const GAS bf16_t* Vg = (const GAS bf16_t*)(unsigned long long)Vh; const GAS unsigned char* Kg = (const GAS unsigned char*)(unsigned long long)Kh;
#pragma unroll
  for (int d0 = 0; d0 < 8; ++d0) qr[d0] = *(const GAS long*)(Qw + d0 * 16);
  const int sr = tid >> 4, sc = (tid & 15) * 8, vst0 = v_st(sr, sc), vst1 = v_st(32 + sr, sc);
  const int vb0 = (int)(uintptr_t)V_lds + v_rd_base(lane);
  struct { bf16x8 vs0, vs1; u32x4 ks; } sr_[2]; const int kr = tid >> 3, kc = (tid & 7) * 2;
#define SLOAD(i, k0) do { sr_[i].vs0 = *(const GAS bf16x8*)(Vg + ((long)((k0) + sr) * LDK + sc)); sr_[i].vs1 = *(const GAS bf16x8*)(Vg + ((long)((k0) + 32 + sr) * LDK + sc)); \
    sr_[i].ks = *(const GAS u32x4*)(Kg + ((long)((k0) + kr) * LDK + kc * 8)); } while (0)
#define SWRITE(b, i) do { *(bf16x8*)((char*)V_lds + (b) * SHM_V + vst0) = sr_[i].vs0;          \
    *(bf16x8*)((char*)V_lds + (b) * SHM_V + vst1) = sr_[i].vs1;               \
    *(u32x2*)(K_lds + (b) * SHM_K + KSWZ8(kr, kc)) = (u32x2){sr_[i].ks.x, sr_[i].ks.y};                       \
    *(u32x2*)(K_lds + (b) * SHM_K + KSWZ8(kr, kc + 1)) = (u32x2){sr_[i].ks.z, sr_[i].ks.w}; } while (0)
#define SWAIT() asm volatile("s_waitcnt vmcnt(3)" ::: "memory")
#define RESC(a) do { if (!FIXED && __any((a) < 1.f)) { if (hi == 0) al_l[r32] = (a); asm volatile("s_waitcnt lgkmcnt(0)" ::: "memory"); \
    for (int d = 0; d < 4; ++d) for (int r = 0; r < 16; ++r) o[d][r] *= al_l[crow(r, hi)]; } } while (0)
  f32x16 pA0, pA1, pB0, pB1; float mnA, mnB, alA, alB; bf16x8 pa0, pa1, pa2, pa3; const int NT = seq / KVBLK;
  constexpr int SE = 0, SO = 1;
  SLOAD(SE, 0); asm volatile("s_waitcnt vmcnt(0)" ::: "memory"); SWRITE(0, SE); __syncthreads();
  qkt(pA0, pA1, K_lds, qr, r32, hi); partialSM<FIXED>(pA0, pA1, m_reg, mnA, alA);
  SLOAD(SO, KVBLK); SLOAD(SE, (2 < NT ? 2 : NT - 1) * KVBLK);
  SWAIT(); SWRITE(1, SO); __syncthreads();
  for (int j = 1; j + 1 < NT; j += 2) {
    SBAR(); qkt(pB0, pB1, K_lds + SHM_K, qr, r32, hi);
    finishSM(pA0, pA1, alA, l_reg, pa0, pa1, pa2, pa3); SBAR();
    SLOAD(SO, (j + 2) * KVBLK); SBAR();
    pv_d0(o, vb0, pa0, pa1, pa2, pa3); partialSM<FIXED>(pB0, pB1, m_reg, mnB, alB);
    __syncthreads(); SWAIT(); SWRITE(0, SE);
    RESC(alB); __syncthreads();
    SBAR(); qkt(pA0, pA1, K_lds, qr, r32, hi);
    finishSM(pB0, pB1, alB, l_reg, pa0, pa1, pa2, pa3); SBAR();
    SLOAD(SE, (j + 3 < NT ? j + 3 : NT - 1) * KVBLK); SBAR();
    pv_d0(o, vb0 + (int)SHM_V, pa0, pa1, pa2, pa3); partialSM<FIXED>(pA0, pA1, m_reg, mnA, alA);
    __syncthreads(); SWAIT(); SWRITE(1, SO);
    RESC(alA); __syncthreads();
  }
  SBAR(); qkt(pB0, pB1, K_lds + SHM_K, qr, r32, hi);
  finishSM(pA0, pA1, alA, l_reg, pa0, pa1, pa2, pa3); SBAR();
  pv_d0(o, vb0, pa0, pa1, pa2, pa3); partialSM<FIXED>(pB0, pB1, m_reg, mnB, alB);
  __syncthreads(); RESC(alB);
  finishSM(pB0, pB1, alB, l_reg, pa0, pa1, pa2, pa3); SBAR();
  pv_d0(o, vb0 + (int)SHM_V, pa0, pa1, pa2, pa3);
  if (hi == 0) li_l[r32] = l_reg; asm volatile("s_waitcnt lgkmcnt(0)" ::: "memory");
  float rli[16];
#pragma unroll
  for (int r = 0; r < 16; ++r) rli[r] = __builtin_amdgcn_rcpf(li_l[crow(r, hi)]);
  GAS bf16_t* Ow = (GAS bf16_t*)(unsigned long long)(Ob + (long)(wid * QBLK) * LDO);
#pragma unroll
  for (int r = 0; r < 16; ++r) { int orow = crow(r, hi);
    for (int d0 = 0; d0 < 4; ++d0) Ow[(long)orow * LDO + d0 * 32 + r32] = (bf16_t)(cvtpk(o[d0][r] * rli[r], 0.f) & 0xffffu); }
  __syncthreads();
#undef SLOAD
#undef SWRITE
#undef SWAIT
#undef RESC
}
#undef KSWZ
#undef SBAR
}

constexpr size_t MiB = 1u << 20;
constexpr size_t WS_CTL = 0, CTL_ZERO_BYTES = 64 * 1024;
constexpr size_t WS_WIN = 1 * MiB, WS_WAB = 55 * MiB, WS_WRB = 51 * MiB, WS_WMO = 59 * MiB, WS_WPQ = 67 * MiB, WS_KBD = 75 * MiB, WS_ROPE = 76 * MiB;
constexpr size_t WS_NWP = 78 * MiB;
constexpr size_t WS_HN = 80 * MiB;
constexpr size_t WS_QA = 148 * MiB, WS_KA = 180 * MiB, WS_VA = WS_KA + 8704 * 1024, WS_QR = 197 * MiB, WS_KR = 229 * MiB, WS_VR = 263 * MiB;
constexpr size_t WS_GR = 331 * MiB, WS_GA = 395 * MiB, WS_GT = 459 * MiB, WS_OATT = 523 * MiB, WS_OF = 555 * MiB, WS_OB = WS_HN;
constexpr size_t WS_RET = 148 * MiB, WS_T = 263 * MiB  , WS_MIX = WS_HN  , WS_X1 = WS_OB  , WS_U = 1 * MiB, WS_V = 25 * MiB  , WS_H2 = WS_HN, WS_PQ = 188 * MiB, WS_SCT = 380 * MiB, WS_OATT8 = 212 * MiB  ;
constexpr size_t WS_RS = 79 * MiB;
constexpr size_t WS_W2 = 619 * MiB, WS_W2Q = 627 * MiB  , WS_MIXQ = WS_OATT   + 0 * MiB  , WS_H2Q = 148 * MiB  ;
constexpr size_t WS_END = 636 * MiB;
static_assert(WS_VA + (size_t)MT * 256 * 2 <= WS_QR && WS_KA + (size_t)MT * 256 * 2 <= WS_VA, "ws map");
constexpr int CW_BAR = 4096;
constexpr int CW_MOD = 131072;
constexpr int CW_DBG = 8192;

constexpr int RING_BYTES = 131072, LDS_BYTES = 147456, MISC_OFF = LDS_BYTES - 256;

#define XB_TMO      128
#define XB_XCNT(j)  (256  + 64 * (j))
#define XB_XSUB(j)  (1280 + 64 * (j))
#define XB_XGEN(j)  (2304 + 64 * (j))
#define XB_TOP      3328
#define XB_TOPGEN   3392
#define XCD_BAR_WORDS 3456
#define XB_SPIN_CAP (1u << 18)
__device__ __forceinline__ unsigned xb_ld(unsigned* p)              { return __hip_atomic_load(p, __ATOMIC_RELAXED, __HIP_MEMORY_SCOPE_AGENT); }
__device__ __forceinline__ unsigned xb_add(unsigned* p, unsigned v) { return __hip_atomic_fetch_add(p, v, __ATOMIC_RELAXED, __HIP_MEMORY_SCOPE_AGENT); }
__device__ __forceinline__ unsigned xb_xcc_id() { return (unsigned)__builtin_amdgcn_s_getreg((3 << 11) | 20) & 0xFu; }
#define XB_SPIN(cond, bar) do { unsigned _sp = 0; while (cond) { __builtin_amdgcn_s_sleep(1); \
    if ((++_sp & 255u) == 0u) { if (xb_ld(&(bar)[XB_TMO])) break; if (_sp > XB_SPIN_CAP) { atomicAdd(&(bar)[XB_TMO], 1u); break; } } } } while (0)
struct XcdBarrier { unsigned* bar; unsigned x; volatile LAS unsigned* st; };
__device__ __forceinline__ XcdBarrier xcd_barrier_post(unsigned* bar, volatile LAS unsigned* st) {
    XcdBarrier b; b.bar = bar; b.x = xb_xcc_id(); b.st = st;
    if (threadIdx.x == 0) (void)xb_add(&bar[XB_XCNT(b.x)], 1u);
    return b;
}
__device__ __forceinline__ void xcd_barrier_complete(unsigned* bar, unsigned x, unsigned& nloc, unsigned& nx) {
    const unsigned G = gridDim.x * gridDim.y * gridDim.z;
    unsigned sum, cnt, mine, sp = 0u;
    for (;;) {
        sum = 0u; cnt = 0u; mine = 0u;
#pragma unroll
        for (unsigned j = 0; j < 16; ++j) { const unsigned c = xb_ld(&bar[XB_XCNT(j)]); sum += c; cnt += (c > 0u) ? 1u : 0u; mine = (j == x) ? c : mine; }
        if (sum == G) break;
        __builtin_amdgcn_s_sleep(1);
        if ((++sp & 255u) == 0u) { if (xb_ld(&bar[XB_TMO])) break; if (sp > XB_SPIN_CAP) { atomicAdd(&bar[XB_TMO], 1u); break; } }
    }
    nloc = mine > 0u ? mine : 1u; nx = cnt > 0u ? cnt : 1u;
}
__device__ __forceinline__ void xcd_barrier(const XcdBarrier& b) {
    asm volatile("s_waitcnt vmcnt(0)" ::: "memory");
    __syncthreads();
    if (threadIdx.x == 0) {
        unsigned* bar = b.bar;
        __builtin_amdgcn_s_waitcnt(0);
        unsigned nloc = b.st[0], nx = b.st[1];
        if (nloc == 0u) { xcd_barrier_complete(bar, b.x, nloc, nx); b.st[0] = nloc; b.st[1] = nx; }
        const unsigned old = xb_add(&bar[XB_XSUB(b.x)], 1u);
        const unsigned gen = old / nloc;
        if (old + 1u == (gen + 1u) * nloc) {
            __builtin_amdgcn_fence(__ATOMIC_RELEASE, "agent");
            asm volatile("s_waitcnt vmcnt(0)" ::: "memory");
            const unsigned og = xb_add(&bar[XB_TOP], 1u);
            const unsigned tg = og / nx;
            if (og + 1u == (tg + 1u) * nx) xb_add(&bar[XB_TOPGEN], 1u);
            else XB_SPIN(xb_ld(&bar[XB_TOPGEN]) == tg, bar);
            __builtin_amdgcn_fence(__ATOMIC_ACQUIRE, "agent");
            xb_add(&bar[XB_XGEN(b.x)], 1u);
            asm volatile("s_waitcnt vmcnt(0)" ::: "memory");
        } else {
            XB_SPIN(xb_ld(&bar[XB_XGEN(b.x)]) == gen, bar);
            __builtin_amdgcn_fence(__ATOMIC_ACQUIRE, "agent");
            asm volatile("s_waitcnt vmcnt(0)" ::: "memory");
        }
    }
    __syncthreads();
}

__device__ __forceinline__ float wave_sum(float v) {
#pragma unroll
    for (int o = 1; o < 64; o <<= 1) v += __shfl_xor(v, o);
    return v;
}
__device__ __forceinline__ float wave_max(float v) {
#pragma unroll
    for (int o = 1; o < 64; o <<= 1) v = fmaxf(v, __shfl_xor(v, o));
    return v;
}
__device__ __forceinline__ float half_sum(float v) {
#pragma unroll
    for (int o = 1; o < 32; o <<= 1) v += __shfl_xor(v, o);
    return v;
}
__device__ __forceinline__ float dpp_row_shr(float v, int n) {
    const int iv = __builtin_bit_cast(int, v); int r;
    switch (n) { case 1: r = __builtin_amdgcn_update_dpp(0, iv, 0x111, 0xf, 0xf, true); break; case 2: r = __builtin_amdgcn_update_dpp(0, iv, 0x112, 0xf, 0xf, true); break;
                 case 4: r = __builtin_amdgcn_update_dpp(0, iv, 0x114, 0xf, 0xf, true); break; default: r = __builtin_amdgcn_update_dpp(0, iv, 0x118, 0xf, 0xf, true); break; }
    return __builtin_bit_cast(float, r);
}
__device__ __forceinline__ float wave_sum_l63(float v) {
    v += dpp_row_shr(v, 1); v += dpp_row_shr(v, 2); v += dpp_row_shr(v, 4); v += dpp_row_shr(v, 8);
    v += __builtin_bit_cast(float, __builtin_amdgcn_update_dpp(0, __builtin_bit_cast(int, v), 0x142, 0xa, 0xf, false));
    v += __builtin_bit_cast(float, __builtin_amdgcn_update_dpp(0, __builtin_bit_cast(int, v), 0x143, 0xc, 0xf, false));
    return v;
}
__device__ __forceinline__ float wave_allsum(float v) {
    return __uint_as_float(__builtin_amdgcn_readlane(__float_as_uint(wave_sum_l63(v)), 63));
}
__device__ __forceinline__ unsigned f2bf(float f) { unsigned u = __builtin_bit_cast(unsigned, f); return (u + 0x7fffu + ((u >> 16) & 1u)) >> 16; }
__device__ __forceinline__ unsigned pk2(float lo, float hi) { return f2bf(lo) | (f2bf(hi) << 16); }
__device__ __forceinline__ float dot2_bf16(unsigned w, unsigned x, float acc) { return __builtin_amdgcn_fdot2_f32_bf16(__builtin_bit_cast(bf16x2_t, w), __builtin_bit_cast(bf16x2_t, x), acc, false); }

struct Args { const float* in[22]; float* out; unsigned char* ws; int ph_lo, ph_hi, pass, pad; };

__device__ __forceinline__ int win_perm(int col) { const bool seg = col < 1280 || (col >= 1536 && col < 3584); if (!seg) return col; const int c = col & 127; return (col & ~127) + 2 * (c & 63) + (c >> 6); }
template <bool PERMROWS, bool I8OUT>
__device__ __forceinline__ void p0_transpose_item(const float* W, int K, int N, bf16_t* WT, LAS float* scr, int item, int lane, float qs = 1.f) {
    const int nblk = N / 64, kb = item / nblk, nb = item % nblk, k0 = 64 * kb, n0 = 64 * nb;
    const int n4 = lane & 15, rg = lane >> 4;
    f32x4 t[16];
#pragma unroll
    for (int i = 0; i < 16; ++i) t[i] = *(const f32x4*)(W + (size_t)(k0 + 4 * i + rg) * N + n0 + 4 * n4);
#pragma unroll
    for (int i = 0; i < 16; ++i) *(LAS f32x4*)(scr + (4 * i + rg) * 68 + 4 * n4) = t[i];
    asm volatile("s_waitcnt lgkmcnt(0)" ::: "memory");
    const LAS float* sc = scr + lane;
    const size_t orow = (size_t)(PERMROWS ? win_perm(n0 + lane) : n0 + lane) * K + k0;
    if constexpr (I8OUT) {
#pragma unroll
        for (int q = 0; q < 4; ++q) { u32x4 o;
#pragma unroll
            for (int e = 0; e < 4; ++e) { const LAS float* s4 = sc + (16 * q + 4 * e) * 68; o[e] = q4_i8((f32x4){s4[0], s4[68], s4[136], s4[204]} * qs); }
            *(u32x4*)((unsigned char*)WT + orow + 16 * q) = o; }
    } else {
#pragma unroll
        for (int q = 0; q < 8; ++q) { const LAS float* s8 = sc + (8 * q) * 68;
            u32x4 o; o.x = pk2(s8[0], s8[68]); o.y = pk2(s8[2 * 68], s8[3 * 68]); o.z = pk2(s8[4 * 68], s8[5 * 68]); o.w = pk2(s8[6 * 68], s8[7 * 68]);
            *(u32x4*)(WT + orow + 8 * q) = o; }
    }
    asm volatile("s_waitcnt lgkmcnt(0)" ::: "memory");
}
__device__ __forceinline__ void p0_convert_item(const float* W, bf16_t* O, int item, int lane) {
    f32x4 a[8], b[8];
#pragma unroll
    for (int i = 0; i < 8; ++i) { const size_t e = (size_t)item * 4096 + (size_t)(i * 64 + lane) * 8; a[i] = *(const f32x4*)(W + e); b[i] = *(const f32x4*)(W + e + 4); }
#pragma unroll
    for (int i = 0; i < 8; ++i) { const size_t e = (size_t)item * 4096 + (size_t)(i * 64 + lane) * 8; *(u32x4*)(O + e) = pg8::pack8(a[i], b[i]); }
}
__device__ __forceinline__ void phase0(const Args& A, LAS unsigned char* lds, int G, int tid, int lane, int wave) {
    unsigned char* ws = A.ws;
    const int gw = blockIdx.x * 8 + wave, NGW = G * 8;
    float* modacc = (float*)(ws + WS_CTL) + CW_MOD;
    {
        const float* cvec = A.in[1]; const float* cctx = A.in[3]; const float* aw = A.in[4]; const float* ab = A.in[5];
        LAS float* sil = (LAS float*)lds;
        LAS float* red = (LAS float*)(lds + 40960);
        if (blockIdx.x < 192) {
            int t1 = threadIdx.x; asm volatile("" : "+v"(t1));
            for (int e = t1; e < 5 * 2048; e += 512) { const int r = e >> 11, k = e & 2047; const float cvv = r < 4 ? cvec[r * 2048 + k] : cctx[k]; sil[e] = cvv * sigm(cvv); }
            __syncthreads();
        }
        for (int it = blockIdx.x; it < 192; it += G) {
            const int n4 = lane & 15, rg = lane >> 4, n = it * 64 + 4 * n4;
            f32x4 acc[5];
#pragma unroll
            for (int r = 0; r < 5; ++r) acc[r] = (f32x4){0.f, 0.f, 0.f, 0.f};
#pragma unroll 1
            for (int ib = 0; ib < 4; ++ib) { f32x4 wv[16];
#pragma unroll
                for (int i = 0; i < 16; ++i) wv[i] = *(const f32x4*)(aw + (size_t)(wave * 256 + ib * 64 + 4 * i + rg) * 12288 + n);
#pragma unroll
                for (int i = 0; i < 16; ++i) { const int k = wave * 256 + ib * 64 + 4 * i + rg;
#pragma unroll
                    for (int r = 0; r < 5; ++r) acc[r] += wv[i] * sil[r * 2048 + k]; } }
#pragma unroll
            for (int r = 0; r < 5; ++r)
#pragma unroll
                for (int e = 0; e < 4; ++e) { float v = acc[r][e]; v += __shfl_xor(v, 16); v += __shfl_xor(v, 32); acc[r][e] = v; }
            __syncthreads();
            if (rg == 0) {
#pragma unroll
                for (int r = 0; r < 5; ++r) *(LAS f32x4*)(red + (wave * 5 + r) * 64 + 4 * n4) = acc[r]; }
            __syncthreads();
            int t2 = threadIdx.x; asm volatile("" : "+v"(t2));
            if (t2 < 320) { const int r = t2 >> 6, cidx = t2 & 63; float sum = ab[it * 64 + cidx];
#pragma unroll
                for (int w8 = 0; w8 < 8; ++w8) sum += red[(w8 * 5 + r) * 64 + cidx];
                modacc[r * 12288 + it * 64 + cidx] = sum; }
        }
        __syncthreads();
    }
    {
        LAS float* scr = (LAS float*)(lds + wave * 17408);
        constexpr int I0 = 32 * 184, I1 = 16 * 32, I2 = 32 * 32, I3 = 32 * 32, I4 = 1024, NIT = I0 + I1 + I2 + I3 + I4;
#define P0_ITEM(IT) do { int r = (IT); \
            if (r < I0) p0_transpose_item<true, true>(A.in[7], 2048, INW, (bf16_t*)(ws + WS_WIN), scr, r, lane, QW_2048); \
            else if ((r -= I0) < I1) p0_transpose_item<false, true>(A.in[13], 1024, 2048, (bf16_t*)(ws + WS_WAB), scr, r, lane, QW_1024); \
            else if ((r -= I1) < I2) p0_transpose_item<false, true>(A.in[14], 2048, 2048, (bf16_t*)(ws + WS_WRB), scr, r, lane, QW_2048); \
            else if ((r -= I2) < I3) p0_transpose_item<false, true>(A.in[15], 2048, 2048, (bf16_t*)(ws + WS_WMO), scr, r, lane, QW_2048); \
            else p0_convert_item(A.in[17], (bf16_t*)(ws + WS_WPQ), (r - I3), lane); } while (0)
        if (G == 256) { constexpr int NA = 2048;
            if (blockIdx.x >= 192) for (int it = ((int)blockIdx.x - 192) * 8 + wave; it < NA; it += 64 * 8) P0_ITEM(it);
            for (int it = NA + gw; it < NIT; it += NGW) P0_ITEM(it);
        } else for (int it = gw; it < NIT; it += NGW) P0_ITEM(it);
#undef P0_ITEM
    }
    {
        const int gt = blockIdx.x * 512 + tid, NT = G * 512;
        f32x2* cs = (f32x2*)(ws + WS_ROPE);
        for (int e = gt; e < SEQ * 64; e += NT) { const int t = e >> 6, i = e & 63;
            const float inv = exp2f(-(float)(i & 31) * (13.287712379549449f / 32.0f)); const float pos = (float)(i < 32 ? (t >> 6) : (t & 63)); const float ang = pos * inv;
            cs[e] = (f32x2){cosf(ang), sinf(ang)}; }
        if (gt < 256) { float* nwp = (float*)(ws + WS_NWP); const int pp = gt & 127; nwp[gt] = (gt < 128 ? A.in[8] : A.in[9])[(pp >> 1) + 64 * (pp & 1)]; }
        bf16_t* kbd = (bf16_t*)(ws + WS_KBD); const float* keys = A.in[18];
        for (int e = gt; e < 8 * 256 * 256; e += NT) { const int j = e >> 16, r = (e >> 8) & 255, k = e & 255, p = r >> 7, n = r & 127;
            const float v = ((k >> 7) == p) ? keys[((size_t)((j * 2 + p) * 128 + n)) * 128 + (k & 127)] : 0.f; kbd[e] = (bf16_t)f2bf(v); }
    }
}

template <int OUT, bool BFIN = false>
__device__ __forceinline__ void norm_mod_row(const float* xr, const float* w, const float* shift, const float* scale, bf16_t* orow, int lane, float* rsout = nullptr, unsigned char* orow8 = nullptr) {
    f32x4 v[8]; float s = 0.f;
#pragma unroll
    for (int j = 0; j < 8; ++j) {
        if constexpr (BFIN) { const u32x2 q = *(const u32x2*)((const bf16_t*)xr + 4 * lane + 256 * j); v[j] = (f32x4){bf_lo(q.x), bf_hi(q.x), bf_lo(q.y), bf_hi(q.y)}; }
        else v[j] = *(const f32x4*)(xr + 4 * lane + 256 * j);
        s += (v[j].x * v[j].x + v[j].y * v[j].y) + (v[j].z * v[j].z + v[j].w * v[j].w); }
    const float rstd = rsqrtf(wave_allsum(s) * (1.f / 2048.f) + EPS);
    float am = 0.f;
#pragma unroll
    for (int j = 0; j < 8; ++j) { const int c = 4 * lane + 256 * j; const f32x4 wv = *(const f32x4*)(w + c), sh = *(const f32x4*)(shift + c), sc = *(const f32x4*)(scale + c);
        v[j] = (v[j] * rstd * wv) * (sc + 1.0f) + sh;
        if constexpr (OUT != 0) am = fmaxf(fmaxf(am, fmaxf(fabsf(v[j].x), fabsf(v[j].y))), fmaxf(fabsf(v[j].z), fabsf(v[j].w)));
        if constexpr (OUT != 1) { u32x2 pk; pk.x = cvt_pk_bf16(v[j].x, v[j].y); pk.y = cvt_pk_bf16(v[j].z, v[j].w); *(u32x2*)(orow + c) = pk; } }
    if constexpr (OUT != 0) {
        am = fmaxf(wave_max(am), 1e-20f); const float qs = 127.f / am; if (lane == 0) *rsout = am * (1.f / 127.f);
        unsigned char* o8 = OUT == 1 ? (unsigned char*)orow : orow8;
#pragma unroll
        for (int j = 0; j < 8; ++j) *(unsigned*)(o8 + 4 * lane + 256 * j) = q4_i8(v[j] * qs); }
}
__device__ __forceinline__ void phase1(const Args& A, int G, int lane, int wave) {
    const int gw = blockIdx.x * 8 + wave, NGW = G * 8;
    const float* modacc = (const float*)(A.ws + WS_CTL) + CW_MOD; bf16_t* HN = (bf16_t*)(A.ws + WS_HN);
#define P1_ROW(R_) do { const int R = (R_); const int b = R / LT, j = R % LT; \
        const float* src = j < LC ? A.in[2] + (size_t)(b * LC + j) * DM : A.in[0] + (size_t)(b * SEQ + j - LC) * DM; \
        const float* md = modacc + (j < LC ? 4 : b) * 12288; \
        norm_mod_row<1>(src, A.in[6], md, md + 2048, (bf16_t*)((unsigned char*)HN + (size_t)R * DM), lane, (float*)(A.ws + WS_RS) + R); } while (0)
    for (int rr = gw; rr < MT; rr += NGW) P1_ROW(rr);
#undef P1_ROW
}

__device__ __forceinline__ void head_fix(bf16_t* hp, const float* nw, const f32x2* cs, float scale, int lp) {
    unsigned* p0 = (unsigned*)(hp + 2 * lp); unsigned* p1 = (unsigned*)(hp + 64 + 2 * lp);
    const unsigned u0 = *p0, u1 = *p1;
    float x1a = bf_lo(u0), x1b = bf_hi(u0), x2a = bf_lo(u1), x2b = bf_hi(u1);
    if (nw) { const float ss = half_sum((x1a * x1a + x1b * x1b) + (x2a * x2a + x2b * x2b)); const float r = rsqrtf(ss * (1.f / 128.f) + EPS);
        x1a *= r * nw[2 * lp]; x1b *= r * nw[2 * lp + 1]; x2a *= r * nw[64 + 2 * lp]; x2b *= r * nw[64 + 2 * lp + 1]; }
    if (cs) { const f32x2 ca = cs[2 * lp], cb = cs[2 * lp + 1];
        const float o1a = x1a * ca.x - x2a * ca.y, o2a = x2a * ca.x + x1a * ca.y, o1b = x1b * cb.x - x2b * cb.y, o2b = x2b * cb.x + x1b * cb.y;
        x1a = o1a; x2a = o2a; x1b = o1b; x2b = o2b; }
    *p0 = cvt_pk_bf16(x1a * scale, x1b * scale); *p1 = cvt_pk_bf16(x2a * scale, x2b * scale);
}
__device__ __forceinline__ void phase3(const Args& A, int G, int lane, int wave) {
    const int gw = blockIdx.x * 8 + wave, NGW = G * 8, lp = lane & 31, hi = lane >> 5;
    unsigned char* ws = A.ws;
    bf16_t *QA = (bf16_t*)(ws + WS_QA), *KA = (bf16_t*)(ws + WS_KA), *QR = (bf16_t*)(ws + WS_QR), *KR = (bf16_t*)(ws + WS_KR);
    const f32x2* cs = (const f32x2*)(ws + WS_ROPE); const float* qnw = A.in[8]; const float* knw = A.in[9];
    for (int R = gw; R < MT; R += NGW) { const int b = R / LT, j = R % LT;
        if (j < LC) { head_fix(KA + (size_t)R * 256 + hi * 128, knw, nullptr, 1.f, lp); continue; }
        const int t = j - LC; const size_t lr = (size_t)b * SEQ + t; const f32x2* ct = cs + (size_t)t * 64;
#pragma unroll
        for (int it = 0; it < 4; ++it) head_fix(QA + lr * 1024 + (2 * it + hi) * 128, qnw, ct, 1.f, lp);
        head_fix(KA + (size_t)R * 256 + hi * 128, knw, ct, 1.f, lp);
#pragma unroll
        for (int it = 0; it < 4; ++it) head_fix(QR + lr * 1024 + (2 * it + hi) * 128, nullptr, ct, 0.088388347648318440f, lp);
#pragma unroll
        for (int it = 0; it < 4; ++it) head_fix(KR + (size_t)R * 1024 + (2 * it + hi) * 128, nullptr, ct, 1.f, lp);
    }
}

namespace ret {
__device__ __forceinline__ u32x4 fp8x8_to_bf16(u32x2 v) {
    const pg8::f32x2c a = __builtin_amdgcn_cvt_pk_f32_fp8((int)v.x, false), b = __builtin_amdgcn_cvt_pk_f32_fp8((int)v.x, true), c = __builtin_amdgcn_cvt_pk_f32_fp8((int)v.y, false), d = __builtin_amdgcn_cvt_pk_f32_fp8((int)v.y, true);
    return (u32x4){cvt_pk_bf16(a[0], a[1]), cvt_pk_bf16(b[0], b[1]), cvt_pk_bf16(c[0], c[1]), cvt_pk_bf16(d[0], d[1])};
}
__device__ __forceinline__ unsigned off_b(unsigned row, unsigned ch) { return 256u * row + 16u * (ch ^ (((row & 3) << 2) | ((row >> 2) & 3))); }
__device__ __forceinline__ unsigned rra16(unsigned lane, unsigned rb, unsigned s) { return off_b((lane & 15) + 16 * rb, 4 * s + (lane >> 4)); }
__device__ __forceinline__ unsigned tra16(unsigned lane, unsigned c, unsigned ks, unsigned t) { const unsigned g = lane >> 4, q = (lane & 15) >> 2, p = lane & 3; return off_b(32 * ks + 8 * g + 4 * t + q, 2 * c + (p >> 1)) + 8 * (p & 1); }
typedef short v4i16 __attribute__((ext_vector_type(4)));
__device__ __forceinline__ bf16x8 rowfrag(LAS unsigned char* tile, unsigned lane, unsigned rb, unsigned s) { return *(LAS bf16x8*)(tile + rra16(lane, rb, s)); }
__device__ __forceinline__ bf16x8 trfrag(LAS unsigned char* tile, unsigned lane, unsigned c, unsigned ks) {
    const v4i16 lo = __builtin_amdgcn_ds_read_tr16_b64_v4i16((LAS v4i16*)(tile + tra16(lane, c, ks, 0)));
    const v4i16 hi = __builtin_amdgcn_ds_read_tr16_b64_v4i16((LAS v4i16*)(tile + tra16(lane, c, ks, 1)));
    return (bf16x8){lo[0], lo[1], lo[2], lo[3], hi[0], hi[1], hi[2], hi[3]};
}
__device__ __forceinline__ void unit2(LAS unsigned char* L, int b, int h, int dir, int dp, int rwave, const bf16_t* QR, const bf16_t* KR, const bf16_t* VR, bf16_t* Oout, float z, unsigned* dbg,
                                     const float* tabU, const float* tabV, unsigned char* t6u, unsigned char* t6v) {
    unsigned ck0 = 0u, ck1 = 0u, ck2 = 0u, ck3 = 0u;
#define CK(acc, v) acc += (v) * 2654435761u + ((v) >> 7)
    int tid_ = threadIdx.x; asm volatile("" : "+v"(tid_), "+v"(z));
    const int tid = tid_, lane = tid & 63, w = __builtin_amdgcn_readfirstlane(tid >> 6);
    LAS unsigned char *Qs = L, *Ks = L + 32768, *Vs = L + 65536, *STs = L + 98304;
    const float lg2 = -__expf(z) * 1.4426950408889634f;
    const float cd = exp2f(lg2 * 128.f);
    const int c16 = tid & 15, r16 = tid >> 4, c8 = tid & 7, r8 = tid >> 3;
    float kdv[2];
#pragma unroll
    for (int i = 0; i < 2; ++i) { const int row = r8 + 64 * i; kdv[i] = dir == 0 ? exp2f(lg2 * (float)(127 - row)) : exp2f(lg2 * (float)row); }
    const int wm = w & 3, wn = w >> 2, l15 = lane & 15, lq = lane >> 4;
    float qd[2], rs[2];
#pragma unroll
    for (int tf = 0; tf < 2; ++tf) { const int tl = wm * 32 + tf * 16 + l15;
        qd[tf] = dir == 0 ? exp2f(lg2 * (float)(tl + 1)) : exp2f(lg2 * (float)(128 - tl));
        rs[tf] = dir == 0 ? exp2f(lg2 * (float)(tl - 127)) : exp2f(-lg2 * (float)tl); }
    f32x4 accST[2][2][2];
#pragma unroll
    for (int sl = 0; sl < 2; ++sl)
#pragma unroll
    for (int a = 0; a < 2; ++a)
#pragma unroll
        for (int c = 0; c < 2; ++c) accST[sl][a][c] = (f32x4){0.f, 0.f, 0.f, 0.f};
    __syncthreads();
    { u32x4 zz = {0u, 0u, 0u, 0u}; for (int q = tid; q < 131072 / 16; q += 512) *(LAS u32x4*)(L + q * 16) = zz; }
    const int kb = w & 3, db = w >> 2;
    u32x2 pq[4], pk[4], pv[2][2];
#define RET_CC(st) (dir == 0 ? (st) : ((st) == 0 ? 1 : ((st) == 1 ? 0 : 35 - (st))))
    const unsigned qoff = (unsigned)(r16 * 1024 + c16 * 8), voff = (unsigned)(r8 * 2048 + c8 * 8);
#define RET_LOAD(st) do { const int cc_ = RET_CC(st); \
        unsigned long long qa_ = (unsigned long long)((const unsigned char*)QR + ((size_t)b * SEQ + (size_t)(cc_ >= 2 ? cc_ - 2 : 0) * 128) * 1024 + h * 128); \
        unsigned long long ka_ = (unsigned long long)((const unsigned char*)KR + ((size_t)b * LT + (size_t)cc_ * 128) * 1024 + h * 128); \
        unsigned long long va_ = (unsigned long long)((const unsigned char*)VR + ((size_t)b * LT + (size_t)cc_ * 128) * 2048 + h * 256 + dp * 128); \
        asm volatile("" : "+s"(qa_), "+s"(ka_), "+s"(va_)); unsigned tt_ = threadIdx.x; asm volatile("" : "+v"(tt_)); const unsigned qo_ = (tt_ >> 4) * 1024u + (tt_ & 15u) * 8u, vo_ = (tt_ >> 3) * 2048u + (tt_ & 7u) * 8u;        \
        const GAS unsigned char* qb_ = (const GAS unsigned char*)qa_; const GAS unsigned char* kb_ = (const GAS unsigned char*)ka_; const GAS unsigned char* vb_ = (const GAS unsigned char*)va_; \
        _Pragma("unroll") for (int i = 0; i < 4; ++i) pq[i] = *(const GAS u32x2*)(qb_ + i * 32768 + qo_);        \
        _Pragma("unroll") for (int i = 0; i < 4; ++i) pk[i] = *(const GAS u32x2*)(kb_ + i * 32768 + qo_); \
        _Pragma("unroll") for (int sl = 0; sl < 2; ++sl) _Pragma("unroll") for (int i = 0; i < 2; ++i) pv[sl][i] = *(const GAS u32x2*)(vb_ + i * 131072 + sl * 64 + vo_); } while (0)
    RET_LOAD(0);
    f32x4 tv[8];
    for (int step = 0; step < 34; ++step) {
        const int cc = RET_CC(step);
        const bool latent = step >= 2;
        const size_t lr0 = (size_t)b * SEQ + (size_t)(cc - 2) * 128;
        __syncthreads();
        if (latent) {
#pragma unroll
            for (int i = 0; i < 4; ++i) *(LAS u32x4*)(Qs + off_b(r16 + 32 * i, c16)) = fp8x8_to_bf16(pq[i]);
        }
#pragma unroll
        for (int i = 0; i < 4; ++i) *(LAS u32x4*)(Ks + off_b(r16 + 32 * i, c16)) = fp8x8_to_bf16(pk[i]);
#pragma unroll
        for (int sl = 0; sl < 2; ++sl)
#pragma unroll
        for (int i = 0; i < 2; ++i) { const int row = r8 + 64 * i; const u32x2 v = pv[sl][i]; const float kd = kdv[i];
            const pg8::f32x2c v0 = __builtin_amdgcn_cvt_pk_f32_fp8((int)v.x, false), v1 = __builtin_amdgcn_cvt_pk_f32_fp8((int)v.x, true), v2 = __builtin_amdgcn_cvt_pk_f32_fp8((int)v.y, false), v3 = __builtin_amdgcn_cvt_pk_f32_fp8((int)v.y, true);
            u32x4 o; o.x = cvt_pk_bf16(v0[0] * kd, v0[1] * kd); o.y = cvt_pk_bf16(v1[0] * kd, v1[1] * kd); o.z = cvt_pk_bf16(v2[0] * kd, v2[1] * kd); o.w = cvt_pk_bf16(v3[0] * kd, v3[1] * kd);
            *(LAS u32x4*)(Vs + off_b(row, sl * 8 + c8)) = o; }
        RET_LOAD(step + 1 < 34 ? step + 1 : 33);
        if (step >= 1 && step <= 32) { const int ps_ = step - 1; const size_t prow = (size_t)((ps_ & 15) * 1024 + rwave + w);
            const u32x6 tpk = pack_fp6(tv, ps_ < 16 ? PEER_SU : PEER_SV); unsigned long long td_ = (unsigned long long)((ps_ < 16 ? t6u : t6v) + prow * 1536); unsigned lo_ = threadIdx.x; asm volatile("" : "+s"(td_)); asm volatile("" : "+v"(lo_)); lo_ = (lo_ & 63u) * 8u;
            GAS unsigned char* tdst = (GAS unsigned char*)td_;
            *(GAS u32x4*)(tdst + 2 * lo_) = (u32x4){tpk[0], tpk[1], tpk[2], tpk[3]}; *(GAS u32x2*)(tdst + 1024 + lo_) = (u32x2){tpk[4], tpk[5]}; }
        const size_t trow = (size_t)((step & 15) * 1024 + rwave + w);
        __syncthreads();
        f32x4 accS[4][2], accC[2][2][2]; u32x2 pS[4][2];
#pragma unroll
        for (int a = 0; a < 4; ++a)
#pragma unroll
            for (int c = 0; c < 2; ++c) accS[a][c] = (f32x4){0.f, 0.f, 0.f, 0.f};
#pragma unroll
        for (int sl = 0; sl < 2; ++sl)
#pragma unroll
        for (int a = 0; a < 2; ++a)
#pragma unroll
            for (int c = 0; c < 2; ++c) accC[sl][a][c] = (f32x4){0.f, 0.f, 0.f, 0.f};
        if (latent) {
#pragma unroll
            for (int ks = 0; ks < 4; ++ks) { bf16x8 qf[2];
#pragma unroll
                for (int tf = 0; tf < 2; ++tf) qf[tf] = rowfrag(Qs, lane, wm * 2 + tf, ks);
#pragma unroll
                for (int tq = 0; tq < 4; ++tq) { const bf16x8 kf = rowfrag(Ks, lane, wn * 4 + tq, ks);
#pragma unroll
                    for (int tf = 0; tf < 2; ++tf) accS[tq][tf] = __builtin_amdgcn_mfma_f32_16x16x32_bf16(kf, qf[tf], accS[tq][tf], 0, 0, 0); }
#pragma unroll
                for (int sl = 0; sl < 2; ++sl)
#pragma unroll
                    for (int dq = 0; dq < 2; ++dq) { const bf16x8 sf = rowfrag(STs + sl * 16384, lane, wn * 2 + dq, ks);
#pragma unroll
                        for (int tf = 0; tf < 2; ++tf) accC[sl][dq][tf] = __builtin_amdgcn_mfma_f32_16x16x32_bf16(sf, qf[tf], accC[sl][dq][tf], 0, 0, 0); } }
#pragma unroll
            for (int sl = 0; sl < 2; ++sl) {
#pragma unroll
            for (int dq = 0; dq < 2; ++dq)
#pragma unroll
                for (int tf = 0; tf < 2; ++tf) accC[sl][dq][tf] *= qd[tf]; }
#pragma unroll
            for (int tq = 0; tq < 4; ++tq)
#pragma unroll
                for (int tf = 0; tf < 2; ++tf) { const int t = wm * 32 + tf * 16 + l15, tp0 = 16 * (wn * 4 + tq) + 4 * lq;
#pragma unroll
                    for (int e = 0; e < 4; ++e) { const int tp = tp0 + e; const bool keep = dir == 0 ? (tp <= t) : (tp >= t); accS[tq][tf][e] = keep ? accS[tq][tf][e] * rs[tf] : 0.f; }
                    pS[tq][tf].x = cvt_pk_bf16(accS[tq][tf][0], accS[tq][tf][1]); pS[tq][tf].y = cvt_pk_bf16(accS[tq][tf][2], accS[tq][tf][3]); }
        }
        __builtin_amdgcn_sched_barrier(0);
#pragma unroll
        for (int sl = 0; sl < 2; ++sl)
#pragma unroll
        for (int kq = 0; kq < 2; ++kq)
#pragma unroll
            for (int dq = 0; dq < 2; ++dq) accST[sl][kq][dq] *= cd;
#pragma unroll
        for (int ks = 0; ks < 4; ++ks) { bf16x8 kfr[2];
#pragma unroll
            for (int q = 0; q < 2; ++q) kfr[q] = trfrag(Ks, lane, kb * 2 + q, ks);
#pragma unroll
            for (int sl = 0; sl < 2; ++sl) { bf16x8 vfr[2];
#pragma unroll
                for (int q = 0; q < 2; ++q) vfr[q] = trfrag(Vs, lane, sl * 4 + db * 2 + q, ks);
#pragma unroll
                for (int kq = 0; kq < 2; ++kq)
#pragma unroll
                    for (int dq = 0; dq < 2; ++dq) accST[sl][kq][dq] = __builtin_amdgcn_mfma_f32_16x16x32_bf16(kfr[kq], vfr[dq], accST[sl][kq][dq], 0, 0, 0); } }
        __syncthreads();
        unsigned pw_ = off_b(wm * 32 + l15, 8 * wn + (lq >> 1)) + 8 * (lq & 1); asm volatile("" : "+v"(pw_));
        if (latent) {
#pragma unroll
            for (int tq = 0; tq < 4; ++tq)
#pragma unroll
                for (int tf = 0; tf < 2; ++tf) *(LAS u32x2*)(Qs + ((pw_ ^ (32u * tq)) + 4096u * tf)) = pS[tq][tf];
        }
#pragma unroll
        for (int sl = 0; sl < 2; ++sl)
#pragma unroll
        for (int kq = 0; kq < 2; ++kq)
#pragma unroll
            for (int dq = 0; dq < 2; ++dq) { const int row = 16 * (db * 2 + dq) + l15, dk0 = 16 * (kb * 2 + kq) + 4 * lq;
                u32x2 pk; pk.x = cvt_pk_bf16(accST[sl][kq][dq][0], accST[sl][kq][dq][1]); pk.y = cvt_pk_bf16(accST[sl][kq][dq][2], accST[sl][kq][dq][3]);
                *(LAS u32x2*)(STs + sl * 16384 + off_b(row, dk0 >> 3) + (dk0 & 7) * 2) = pk; }
        { unsigned long long ta_ = (unsigned long long)((step < 16 ? tabU : tabV) + trow * 2048); unsigned lo_ = threadIdx.x; asm volatile("" : "+s"(ta_)); asm volatile("" : "+v"(lo_)); lo_ = (lo_ & 63u) * 16u;
            const GAS unsigned char* tsrc = (const GAS unsigned char*)ta_;
#pragma unroll
            for (int i = 0; i < 8; ++i) tv[i] = *(const GAS f32x4*)(tsrc + 1024 * i + lo_); }
        __syncthreads();
        if (latent) {
#pragma unroll
            for (int ks = 0; ks < 4; ++ks) { bf16x8 sfr[2];
#pragma unroll
                for (int q = 0; q < 2; ++q) sfr[q] = rowfrag(Qs, lane, wm * 2 + q, ks);
#pragma unroll
                for (int sl = 0; sl < 2; ++sl) { bf16x8 vf[2];
#pragma unroll
                    for (int q = 0; q < 2; ++q) vf[q] = trfrag(Vs, lane, sl * 4 + wn * 2 + q, ks);
#pragma unroll
                    for (int dq = 0; dq < 2; ++dq)
#pragma unroll
                        for (int tf = 0; tf < 2; ++tf) accC[sl][dq][tf] = __builtin_amdgcn_mfma_f32_16x16x32_bf16(vf[dq], sfr[tf], accC[sl][dq][tf], 0, 0, 0); } }
            { unsigned long long oa_ = (unsigned long long)(Oout + lr0 * 2048 + h * 256 + dp * 128) + (unsigned)((wm * 32 * 2048 + 32 * wn) * 2); unsigned oo_ = threadIdx.x; asm volatile("" : "+s"(oa_)); asm volatile("" : "+v"(oo_)); oo_ = (oo_ & 15u) * 4096u + ((oo_ >> 4) & 3u) * 8u;
              GAS unsigned char* ob_ = (GAS unsigned char*)oa_;
#pragma unroll
            for (int sl = 0; sl < 2; ++sl)
#pragma unroll
            for (int dq = 0; dq < 2; ++dq)
#pragma unroll
                for (int tf = 0; tf < 2; ++tf) {
                    u32x2 pk; pk.x = cvt_pk_bf16(accC[sl][dq][tf][0], accC[sl][dq][tf][1]); pk.y = cvt_pk_bf16(accC[sl][dq][tf][2], accC[sl][dq][tf][3]);
                    *(GAS u32x2*)(ob_ + (tf * 16 * 2048 + sl * 64 + dq * 16) * 2 + oo_) = pk; } }
        }
    }
    __syncthreads();
    if (dbg && dir == 0) { atomicAdd(dbg + 16, ck0); atomicAdd(dbg + 17, ck1); atomicAdd(dbg + 18, ck2); atomicAdd(dbg + 19, ck3); }
#undef CK
}
}

__device__ __forceinline__ void w2_quant(const Args& A, int G, int lane, int wave) {
    const int gw = blockIdx.x * 8 + wave, NGW = G * 8; unsigned char* ws = A.ws;
    for (int r = gw; r < 2048; r += NGW) { const bf16_t* wr_ = (const bf16_t*)(ws + WS_W2) + (size_t)r * 2048; f32x4 y[8]; float am = 0.f;
#pragma unroll
        for (int j = 0; j < 8; ++j) { const u32x2 q = *(const u32x2*)(wr_ + 4 * lane + 256 * j); y[j] = (f32x4){bf_lo(q.x), bf_hi(q.x), bf_lo(q.y), bf_hi(q.y)};
            am = fmaxf(fmaxf(am, fmaxf(fabsf(y[j].x), fabsf(y[j].y))), fmaxf(fabsf(y[j].z), fabsf(y[j].w))); }
        am = fmaxf(wave_max(am), 1e-20f); const float qs = 127.f / am; if (lane == 0) ((float*)(ws + WS_RS))[98304 + r] = am * (1.f / 127.f);
#pragma unroll
        for (int j = 0; j < 8; ++j) *(unsigned*)(ws + WS_W2Q + (size_t)r * 2048 + 4 * lane + 256 * j) = q4_i8(y[j] * qs); }
}
__device__ __forceinline__ void phase5(const Args& A, int row0, int lane, int wave) {
    unsigned char* ws = A.ws;
    const bf16_t *OF = (const bf16_t*)(ws + WS_OF), *OB = (const bf16_t*)(ws + WS_OB), *GR = (const bf16_t*)(ws + WS_GR); bf16_t* RET = (bf16_t*)(ws + WS_RET);
    const float* rw = A.in[12];
    float* rsO = (float*)(ws + WS_RS) + 32768; float* rsR = (float*)(ws + WS_RS) + 65536;
    const bf16_t* OA = (const bf16_t*)(ws + WS_OATT); unsigned char* OA8 = ws + WS_OATT8; unsigned char* RET8 = (unsigned char*)RET;
#pragma unroll 1
    for (int rk = 0; rk < 8; ++rk) { const int r = row0 + wave * 8 + rk;
        const size_t base = (size_t)r * 2048;
        f32x4 y[8]; float am = 0.f, ssr = 0.f;
#pragma unroll
        for (int j = 0; j < 8; ++j) { const int c = 4 * lane + 256 * j;
            const u32x2 a = *(const u32x2*)(OF + base + c), bq = *(const u32x2*)(OB + base + c); const unsigned g = *(const unsigned*)((const unsigned char*)GR + base + c);
            const pg8::f32x2c g01 = __builtin_amdgcn_cvt_pk_f32_fp8((int)g, false), g23 = __builtin_amdgcn_cvt_pk_f32_fp8((int)g, true);
            f32x4 o = {bf_lo(a.x) + bf_lo(bq.x), bf_hi(a.x) + bf_hi(bq.x), bf_lo(a.y) + bf_lo(bq.y), bf_hi(a.y) + bf_hi(bq.y)};
            const float mu = wave_allsum((o.x + o.y) + (o.z + o.w)) * (1.f / 256.f);
            o = o - mu;
            const float var = wave_allsum((o.x * o.x + o.y * o.y) + (o.z * o.z + o.w * o.w)) * (1.f / 256.f);
            const float rstd = rsqrtf(var + EPS);
            const f32x4 wv = *(const f32x4*)(rw + c);
            y[j] = o * rstd * wv * (f32x4){g01[0], g01[1], g23[0], g23[1]}; ssr += (y[j].x * y[j].x + y[j].y * y[j].y) + (y[j].z * y[j].z + y[j].w * y[j].w);
            am = fmaxf(fmaxf(am, fmaxf(fabsf(y[j].x), fabsf(y[j].y))), fmaxf(fabsf(y[j].z), fabsf(y[j].w))); }
        am = fmaxf(wave_max(am), 1e-20f); { const float qs = 127.f / am; if (lane == 0) rsR[r] = am * (1.f / 127.f);
#pragma unroll
            for (int j = 0; j < 8; ++j) *(unsigned*)(RET8 + base + 4 * lane + 256 * j) = q4_i8(y[j] * qs); }
        { const u32x4 w0 = *(const u32x4*)(OA + (size_t)r * 1024 + 8 * lane), w1 = *(const u32x4*)(OA + (size_t)r * 1024 + 512 + 8 * lane);
          float a2 = 0.f, sso = 0.f;
#pragma unroll
          for (int q = 0; q < 4; ++q) { a2 = fmaxf(fmaxf(a2, fmaxf(fabsf(bf_lo(w0[q])), fabsf(bf_hi(w0[q])))), fmaxf(fabsf(bf_lo(w1[q])), fabsf(bf_hi(w1[q]))));
              sso += (bf_lo(w0[q]) * bf_lo(w0[q]) + bf_hi(w0[q]) * bf_hi(w0[q])) + (bf_lo(w1[q]) * bf_lo(w1[q]) + bf_hi(w1[q]) * bf_hi(w1[q])); }
          { const float so_ = wave_allsum(sso) * (1.f / 1024.f); const float sb = sqrtf(so_ + wave_allsum(ssr) * (1.f / 2048.f)); const float mx = fmaxf(4.f * sb, 1e-20f);
            const float mt = fmaxf(4.f * sqrtf(so_), 1e-20f);
            if (lane == 0) { float* rs_ = (float*)(ws + WS_RS); rs_[163840 + r] = mx * (1.f / 127.f); rs_[180224 + r] = 127.f / mx; rs_[196608 + r] = mt * (1.f / 127.f); rs_[212992 + r] = 127.f / mt; } }
          a2 = fmaxf(wave_max(a2), 1e-20f); const float qs = 127.f / a2; if (lane == 0) rsO[r] = a2 * (1.f / 127.f);
          u32x2 o0, o1;
          o0.x = q4_i8((f32x4){bf_lo(w0.x), bf_hi(w0.x), bf_lo(w0.y), bf_hi(w0.y)} * qs); o0.y = q4_i8((f32x4){bf_lo(w0.z), bf_hi(w0.z), bf_lo(w0.w), bf_hi(w0.w)} * qs);
          o1.x = q4_i8((f32x4){bf_lo(w1.x), bf_hi(w1.x), bf_lo(w1.y), bf_hi(w1.y)} * qs); o1.y = q4_i8((f32x4){bf_lo(w1.z), bf_hi(w1.z), bf_lo(w1.w), bf_hi(w1.w)} * qs);
          *(u32x2*)(OA8 + (size_t)r * 1024 + 8 * lane) = o0; *(u32x2*)(OA8 + (size_t)r * 1024 + 512 + 8 * lane) = o1; }
    }
}

__device__ __forceinline__ void phase9(const Args& A, int row0, int tid, int lane, int wave) {
    unsigned char* ws = A.ws;
    const float* modacc = (const float*)(ws + WS_CTL) + CW_MOD; const bf16_t* X1 = (const bf16_t*)(ws + WS_X1); bf16_t* H2 = (bf16_t*)(ws + WS_H2);
#pragma unroll 1
    for (int rk = 0; rk < 8; ++rk) { const int r = row0 + wave * 8 + rk; const float* md = modacc + (r / SEQ) * 12288;
        norm_mod_row<1, true>((const float*)(X1 + (size_t)r * DM), A.in[16], md + 3 * 2048, md + 4 * 2048, (bf16_t*)(ws + WS_H2Q + (size_t)r * DM), lane, (float*)(ws + WS_RS) + 131072 + r); }
}

__device__ __forceinline__ float med3f(float a, float b, float c) { return __builtin_amdgcn_fmed3f(a, b, c); }
#define TOPK_INSERT(L, key) do { _Pragma("unroll") for (int _j = 15; _j >= 1; --_j) L[_j] = med3f(L[_j], L[_j - 1], (key)); L[0] = fmaxf(L[0], (key)); } while (0)
__device__ __forceinline__ float gelu_tanh(float a) { const float z = 0.7978845608028654f * (a + 0.044715f * a * a * a); const float t = 1.f - 2.f * __builtin_amdgcn_rcpf(1.f + __expf(2.f * z)); return 0.5f * a * (1.f + t); }
__device__ __forceinline__ void phase12(const Args& A, LAS unsigned char* lds, int G, int tid, int lane, int wave, int tokblk, const _Float16* SCT  , int sctc0) {
    unsigned char* ws = A.ws;
    const bf16_t* X1 = (const bf16_t*)(ws + WS_X1); const unsigned char* H2Q = ws + WS_H2Q; const float* rsH2 = (const float*)(ws + WS_RS) + 131072;
    const unsigned char* U8 = ws + WS_U; const unsigned char* V8 = ws + WS_V;
    const float* modacc = (const float*)(ws + WS_CTL) + CW_MOD; const float* nfw = A.in[21];
    LAS unsigned* ab = (LAS unsigned*)lds;
    LAS unsigned* res_e = (LAS unsigned*)(lds + 65536);
    LAS float* res_g = (LAS float*)(lds + 65536 + 33024);
    LAS unsigned* srt_e = (LAS unsigned*)lds;
    LAS float* srt_g = (LAS float*)(lds + 32768);
    LAS float* act_s = srt_g; LAS unsigned* act_u = (LAS unsigned*)srt_g;
    LAS float* a_s = (LAS float*)(lds + 65536);
    LAS unsigned* offs = (LAS unsigned*)(lds + 65536 + 2 * 33024);
    if (G != ML / 64) return;
    { const int tb = tokblk;
        const int t0 = tb * 64;
        __syncthreads();
        {
            const int h = wave; const _Float16* sp = SCT + (size_t)(h * 256) * 256 + sctc0 + lane;
            float La[16], Lb[16], Lc[16];
#pragma unroll
            for (int i = 0; i < 16; ++i) { La[i] = -INFINITY; Lb[i] = -INFINITY; Lc[i] = -INFINITY; }
#pragma unroll 32
            for (int n = 0; n < 128; ++n) { const float s = (float)sp[(size_t)n * 256]; const float key = __uint_as_float((__float_as_uint(s) & ~127u) | (unsigned)n); TOPK_INSERT(La, key); }
#pragma unroll 32
            for (int n = 0; n < 128; ++n) { const float s = (float)sp[(size_t)(128 + n) * 256]; const float key = __uint_as_float((__float_as_uint(s) & ~127u) | (unsigned)n); TOPK_INSERT(Lb, key); }
#pragma unroll
            for (int i = 0; i < 16; ++i) { ab[i * 512 + tid] = __float_as_uint(La[i]); ab[(16 + i) * 512 + tid] = __float_as_uint(Lb[i]); }
#pragma unroll
            for (int i = 0; i < 16; ++i)
#pragma unroll
                for (int j = 0; j < 16; ++j) if ((i + 1) * (j + 1) <= 16) { const float c = La[i] + Lb[j]; const float key = __uint_as_float((__float_as_uint(c) & ~255u) | (unsigned)(i * 16 + j)); TOPK_INSERT(Lc, key); }
            float p[16], sum = 0.f;
#pragma unroll
            for (int k = 0; k < 16; ++k) { p[k] = __expf(Lc[k] - Lc[0]); sum += p[k]; }
            const float inv = 1.f / sum;
            int lane3 = lane; asm volatile("" : "+v"(lane3));
            const int rbase = lane3 * 129 + h * 16;
#pragma unroll
            for (int k = 0; k < 16; ++k) { const unsigned code = __float_as_uint(Lc[k]) & 255u; const unsigned ia = ab[(code >> 4) * 512 + tid] & 127u, ib = ab[(16 + (code & 15u)) * 512 + tid] & 127u;
                res_e[rbase + k] = ia * 128u + ib; res_g[rbase + k] = p[k] * inv; }
        }
        __syncthreads();
        {
            int lane_ = tid & 63; asm volatile("" : "+v"(lane_)); const int lane = lane_;
            const int tl0 = wave * 8;
#pragma unroll 1
            for (int j = 0; j < 8; ++j) { const int tl = tl0 + j;
                const unsigned e0 = res_e[tl * 129 + lane], e1 = res_e[tl * 129 + 64 + lane]; const float g0 = res_g[tl * 129 + lane], g1 = res_g[tl * 129 + 64 + lane];
                const unsigned s0 = e0 >> 9, s1 = e1 >> 9; unsigned pos0 = 0, pos1 = 0; unsigned off = 0;
#pragma unroll 1
                for (unsigned bb = 0; bb < 32; ++bb) { const unsigned long long m0 = __ballot(s0 == bb), m1 = __ballot(s1 == bb);
                    const unsigned c0 = __popcll(m0), c1 = __popcll(m1);
                    const unsigned r0 = __builtin_amdgcn_mbcnt_hi((unsigned)(m0 >> 32), __builtin_amdgcn_mbcnt_lo((unsigned)m0, 0u)), r1 = __builtin_amdgcn_mbcnt_hi((unsigned)(m1 >> 32), __builtin_amdgcn_mbcnt_lo((unsigned)m1, 0u));
                    if (s0 == bb) pos0 = off + r0; if (s1 == bb) pos1 = off + c0 + r1;
                    if (lane == 0) offs[tl * 33 + bb] = off;
                    off += c0 + c1; }
                if (lane == 0) offs[tl * 33 + 32] = off;
                srt_e[tl * 128 + pos0] = e0; srt_g[tl * 128 + pos0] = g0; srt_e[tl * 128 + pos1] = e1; srt_g[tl * 128 + pos1] = g1; }
            __syncthreads();
            const int cc = lane & 15, gg = lane >> 4, l32 = lane & 31, hw = lane >> 5;
            f32x4 dmask; { const bool vd = (cc >> 2) == gg; dmask[0] = (vd && (cc & 3) == 0) ? 1.f : 0.f; dmask[1] = (vd && (cc & 3) == 1) ? 1.f : 0.f; dmask[2] = (vd && (cc & 3) == 2) ? 1.f : 0.f; dmask[3] = (vd && (cc & 3) == 3) ? 1.f : 0.f; }
            const unsigned l16 = 16u * (unsigned)lane, l8 = 1024u + 8u * (unsigned)lane;
#define U64(v, h) ((long)(((unsigned long long)(v)[2 * (h) + 1] << 32) | (v)[2 * (h)]))
            {
#pragma unroll 1
              for (int gu = 0; gu < 2; ++gu) {
                const int tlu = tl0 + 4 * gu;
                i32x8 hq[4]; float hinv[4];
#pragma unroll
                for (int t8 = 0; t8 < 4; ++t8) { const size_t tk = (size_t)t0 + tlu + t8; f32x4 v[8];
#pragma unroll
                    for (int i = 0; i < 8; ++i) { const unsigned hv = *(const unsigned*)(H2Q + tk * 2048 + 256 * i + 4 * lane);
                        v[i] = (f32x4){(float)(int)(signed char)(hv & 255u), (float)(int)(signed char)((hv >> 8) & 255u), (float)(int)(signed char)((hv >> 16) & 255u), (float)((int)hv >> 24)}; }
                    hinv[t8] = rsH2[tk] * (127.f / (7.5f * PEER_SU));
                    const u32x6 pk = pack_fp6(v, 7.5f / 127.f); hq[t8] = (i32x8){(int)pk[0], (int)pk[1], (int)pk[2], (int)pk[3], (int)pk[4], (int)pk[5], 0, 0}; }
                u32x4 ur4[4][UQ]; u32x2 ur2[4][UQ];
#define UP_LD(T, C) do { _Pragma("unroll") for (int q = 0; q < UQ; ++q) { const unsigned e_ = __builtin_amdgcn_readfirstlane(srt_e[(tlu + (T)) * 128 + UQ * (C) + q]); \
            const unsigned ro_ = e_ * 1536u; ur4[T][q] = *(const u32x4*)(U8 + (ro_ + l16)); ur2[T][q] = *(const u32x2*)(U8 + (ro_ + l8)); } } while (0)
#define UP_MM(T, C) do { f32x4 P_[UQ]; \
            _Pragma("unroll") for (int q = 0; q < UQ; ++q) { const i32x8 A_ = {(int)ur4[T][q].x, (int)ur4[T][q].y, (int)ur4[T][q].z, (int)ur4[T][q].w, (int)ur2[T][q].x, (int)ur2[T][q].y, 0, 0}; \
                P_[q] = __builtin_amdgcn_mfma_scale_f32_16x16x128_f8f6f4(A_, hq[T], (f32x4){0.f, 0.f, 0.f, 0.f}, 2, 2, 0, 127, 0, 127); } \
            float r_[UQ]; _Pragma("unroll") for (int q = 0; q < UQ; ++q) r_[q] = (P_[q][0] * dmask[0] + P_[q][1] * dmask[1]) + (P_[q][2] * dmask[2] + P_[q][3] * dmask[3]); \
            _Pragma("unroll") for (int q = 0; q < UQ; ++q) r_[q] += dpp_row_shr(r_[q], 1); \
            _Pragma("unroll") for (int q = 0; q < UQ; ++q) r_[q] += dpp_row_shr(r_[q], 2); \
            _Pragma("unroll") for (int q = 0; q < UQ; ++q) r_[q] += dpp_row_shr(r_[q], 4); \
            _Pragma("unroll") for (int q = 0; q < UQ; ++q) r_[q] += dpp_row_shr(r_[q], 8); \
            _Pragma("unroll") for (int q = 0; q < UQ; ++q) r_[q] += __builtin_bit_cast(float, __builtin_amdgcn_update_dpp(0, __builtin_bit_cast(int, r_[q]), 0x142, 0xa, 0xf, false)); \
            _Pragma("unroll") for (int q = 0; q < UQ; ++q) r_[q] += __builtin_bit_cast(float, __builtin_amdgcn_update_dpp(0, __builtin_bit_cast(int, r_[q]), 0x143, 0xc, 0xf, false)); \
            if (lane == 63) { _Pragma("unroll") for (int q = 0; q < UQ; ++q) a_s[(tlu + (T)) * 128 + UQ * (C) + q] = r_[q] * hinv[T]; } } while (0)
                UP_LD(0, 0); UP_LD(1, 0); UP_LD(2, 0); UP_LD(3, 0);
#pragma unroll 1
                for (int c = 0; c < 128 / UQ - 1; ++c) {
                    if ((c & (2 * PEER_SYNC / UQ - 1)) == 0) __builtin_amdgcn_s_barrier();
                    UP_MM(0, c); UP_LD(0, c + 1);
                    UP_MM(1, c); UP_LD(1, c + 1);
                    UP_MM(2, c); UP_LD(2, c + 1);
                    UP_MM(3, c); UP_LD(3, c + 1);
                }
                UP_MM(0, 128 / UQ - 1); UP_MM(1, 128 / UQ - 1); UP_MM(2, 128 / UQ - 1); UP_MM(3, 128 / UQ - 1);
#undef UP_LD
#undef UP_MM
              }
#pragma unroll 1
                for (int t8 = 0; t8 < 8; ++t8) { const int bi = (tl0 + t8) * 128 + lane;
                    const float a0 = a_s[bi], a1 = a_s[bi + 64];
                    act_s[bi] = gelu_tanh(a0) * srt_g[bi]; act_s[bi + 64] = gelu_tanh(a1) * srt_g[bi + 64]; }
            }
#pragma unroll 1
            for (int grp = 0; grp < 2; ++grp) {
                f32x4 o[4][8];
#pragma unroll
                for (int t4 = 0; t4 < 4; ++t4)
#pragma unroll
                    for (int i = 0; i < 8; ++i) o[t4][i] = (f32x4){0.f, 0.f, 0.f, 0.f};
                const int tlg = tl0 + 4 * grp;
                u32x4 vr4[4][2]; u32x2 vr2[4][2];
#define VP_LD(T, C) do { const u32x2 ee_ = *(const LAS u32x2*)(srt_e + (tlg + (T)) * 128 + 2 * (C)); \
            _Pragma("unroll") for (int q = 0; q < 2; ++q) { const unsigned ro_ = (unsigned)__builtin_amdgcn_readfirstlane(ee_[q]) * 1536u; \
            vr4[T][q] = *(const u32x4*)(V8 + (ro_ + l16)); vr2[T][q] = *(const u32x2*)(V8 + (ro_ + l8)); } } while (0)
#define VP_MM(T, C) do { const u32x2 aa_ = *(const LAS u32x2*)(act_u + (tlg + (T)) * 128 + 2 * (C)); \
            _Pragma("unroll") for (int q = 0; q < 2; ++q) { const float ac_ = __uint_as_float(__builtin_amdgcn_readfirstlane(aa_[q])); \
            const u32x6 pk_ = {vr4[T][q].x, vr4[T][q].y, vr4[T][q].z, vr4[T][q].w, vr2[T][q].x, vr2[T][q].y}; f32x32 r_ = __builtin_amdgcn_cvt_scalef32_pk32_f32_fp6(pk_, 1.0f); \
            _Pragma("unroll") for (int i = 0; i < 8; ++i) o[T][i] += (f32x4){r_[4 * i], r_[4 * i + 1], r_[4 * i + 2], r_[4 * i + 3]} * ac_; } } while (0)
                VP_LD(0, 0); VP_LD(1, 0); VP_LD(2, 0); VP_LD(3, 0);
#pragma unroll 1
                for (int c = 0; c < 63; ++c) {
                    if ((c & (PEER_SYNC - 1)) == 0) __builtin_amdgcn_s_barrier();
                    VP_MM(0, c); VP_LD(0, c + 1);
                    VP_MM(1, c); VP_LD(1, c + 1);
                    VP_MM(2, c); VP_LD(2, c + 1);
                    VP_MM(3, c); VP_LD(3, c + 1);
                }
                VP_MM(0, 63); VP_MM(1, 63); VP_MM(2, 63); VP_MM(3, 63);
                __builtin_amdgcn_sched_barrier(0);
#undef VP_LD
#undef VP_MM
                int le_ = threadIdx.x & 63; asm volatile("" : "+v"(le_));
#pragma unroll
                for (int t4 = 0; t4 < 4; ++t4) { const size_t tk = (size_t)t0 + tl0 + 4 * grp + t4;
                    __builtin_amdgcn_sched_barrier(0);
                    const float* md = modacc + (tk / SEQ) * 12288 + 5 * 2048; float ss = 0.f;
#pragma unroll
                    for (int i = 0; i < 8; ++i) { const int c = 256 * i + 4 * le_; const u32x2 xq_ = *(const u32x2*)(X1 + tk * 2048 + c); const f32x4 x1 = {bf_lo(xq_.x), bf_hi(xq_.x), bf_lo(xq_.y), bf_hi(xq_.y)}, g = *(const f32x4*)(md + c);
                        const f32x4 x2 = x1 + g * (o[t4][i] * (1.f / PEER_SV)); o[t4][i] = x2; ss += (x2.x * x2.x + x2.y * x2.y) + (x2.z * x2.z + x2.w * x2.w); }
                    const float rstd = rsqrtf(wave_allsum(ss) * (1.f / 2048.f) + EPS);
#pragma unroll
                    for (int i = 0; i < 8; ++i) { const int c = 256 * i + 4 * le_; const f32x4 wv = *(const f32x4*)(nfw + c);
                        *(f32x4*)(A.out + tk * 2048 + c) = o[t4][i] * rstd * wv; } }
            }
#undef U64
        }
    }
}

struct Sched1 {
    int G, c; const char* A; const char* B;
    __device__ __forceinline__ bool next(int i, pg8::Unit& u) const {
        constexpr int NU = 3000, NL = 2944;
        const long L = (long)i * G + c; if (L >= NU) return false;
        int wgid = (int)L; { const int q = NU / 8, xcd = wgid % 8, off = wgid / 8; wgid = xcd * q + off; }
        int pm, pn;
        if (wgid < NL) { const int gid = wgid / 368, wq = wgid % 368, lt = gid * 8 + (wq % 8); pn = wq / 8; pm = (lt / 16) * 17 + 1 + (lt % 16); }
        else { const int wq = wgid - NL, cb = wq % 4, ci = wq / 4; pm = cb * 17; pn = ci < 2 ? 4 + ci : 8 + ci; }
        u.pm = pm; u.pn = pn; u.a = A + (size_t)pm * (256 * 2048); u.b = B + (size_t)pn * (256 * 2048); return true;
    }
};
struct SchedS {
    int G, c; const char* KBD; const char* PQ;
    __device__ __forceinline__ bool next(int i, pg8::Unit& u) const {
        const int L = i * G + c; if (L >= 512) return false;
        const int j = L & 7, tt = L >> 3; u.pm = j; u.pn = tt; u.a = KBD + (size_t)j * (256 * 256 * 2); u.b = PQ + ((size_t)tt * 256 * 2048 + (size_t)j * 256) * 2; return true;
    }
};


#ifdef MK_DEBUG
__device__ __forceinline__ void dbg_scan(unsigned* ctl, int pass, int flag, const void* ptr, size_t nbytes, int G, int tid) {
    const size_t gt = (size_t)blockIdx.x * 512 + tid, NT = (size_t)G * 512; unsigned acc = 0u;
    const unsigned* p = (const unsigned*)ptr; const size_t n = nbytes / 4; for (size_t i = gt; i < n; i += NT) { const unsigned v = p[i]; acc += v * 2654435761u + (v >> 7); }
    atomicAdd(ctl + CW_DBG + 64 * pass + flag, acc);
}
#define DBG_SCAN(flag, off, bytes, f32) dbg_scan(ctl, args.pass, flag, ws + (off), (size_t)(bytes), G, tid)
#else
#define DBG_SCAN(flag, off, bytes, f32) do {} while (0)
#endif
struct SchedW2 {
    int G, c; const char* KBD; const char* WQ;
    __device__ __forceinline__ bool next(int i, pg8::Unit& u) const {
        const int L = i * G + c; if (L >= 64) return false;
        const int j = L & 7, dt = L >> 3; u.pm = j; u.pn = dt; u.a = KBD + (size_t)j * (256 * 256 * 2); u.b = WQ + ((size_t)dt * 256 * 2048 + (size_t)j * 256) * 2; return true;
    }
};
struct TeamRowSched {
    int team, mem, n; const char* A; const char* B; size_t ta, tb;
    __device__ __forceinline__ bool next(int i, pg8::Unit& u) const { if (i >= n) return false; u.pm = team; u.pn = 2 * mem + i; u.a = A + (size_t)team * ta; u.b = B + (size_t)u.pn * tb; return true; }
};
struct TeamKeySched {
    int team, mem, n; const char* A; const char* B; size_t ta, tb;
    __device__ __forceinline__ bool next(int i, pg8::Unit& u) const { if (i >= n) return false; u.pm = 2 * mem + i; u.pn = 0; u.a = A + (size_t)u.pm * ta; u.b = B + (size_t)team * tb; return true; }
};
__device__ __forceinline__ void team_barrier(unsigned* bar, unsigned* cnt, unsigned target, bool same_xcd) {
    asm volatile("s_waitcnt vmcnt(0)" ::: "memory");
    __syncthreads();
    if (threadIdx.x == 0) {
        if (!same_xcd) __builtin_amdgcn_fence(__ATOMIC_RELEASE, "agent");
        asm volatile("s_waitcnt vmcnt(0)" ::: "memory");
        (void)xb_add(cnt, 1u);
        XB_SPIN(xb_ld(cnt) < target, bar);
        __builtin_amdgcn_fence(__ATOMIC_ACQUIRE, "agent");
        asm volatile("s_waitcnt vmcnt(0)" ::: "memory");
    }
    __syncthreads();
}
constexpr int NPH = 13;
__global__ void __launch_bounds__(512, 2) mk_fwd(Args args) {
    extern __shared__ __attribute__((aligned(16))) unsigned char lds_raw[];
    LAS unsigned char* lds = (LAS unsigned char*)lds_raw;
    volatile LAS unsigned* MISC = (volatile LAS unsigned*)(lds + MISC_OFF);
    const int wave = __builtin_amdgcn_readfirstlane(threadIdx.x >> 6), G = gridDim.x;
#define FRESH_TID int tid_ = threadIdx.x; asm volatile("" : "+v"(tid_)); const int tid = tid_, lane = tid & 63; (void)lane
    unsigned char* ws = args.ws;
    unsigned* ctl = (unsigned*)(ws + WS_CTL);
    for (int u = threadIdx.x; u < (LDS_BYTES - RING_BYTES) / 4; u += 512) ((LAS unsigned*)(lds + RING_BYTES))[u] = 0u;
    __syncthreads();
    if (threadIdx.x == 0) ctl[2048 + blockIdx.x] = xb_xcc_id() + 1u;
    XcdBarrier bar; bar.bar = ctl + CW_BAR; bar.x = 0; bar.st = nullptr;
    if (MK_N_LAUNCHES == 1) bar = xcd_barrier_post(ctl + CW_BAR, MISC + 8);
    const int lo = args.ph_lo, hi = args.ph_hi;
#ifndef PH_MASK
#define PH_MASK 0x1fff
#endif
#define IN(k) (((PH_MASK >> (k)) & 1) && lo <= (k) && (k) < hi)
#define SEAM(k) do { if (IN(k) && (k) + 1 < hi) xcd_barrier(bar); } while (0)
    const int bx = blockIdx.x;

#ifdef MK_DEBUG
    if (lo >= 100) {
        const int k = lo - 100;
        if (k == 0) { DBG_SCAN(0, WS_WIN, 75 * MiB, false); DBG_SCAN(0, WS_ROPE, 2 * MiB, true); DBG_SCAN(0, WS_CTL + CW_MOD * 4, 5 * 12288 * 4, true); }
        if (k == 1) DBG_SCAN(1, WS_HN, (size_t)MT * 2048 * 2, false);
        if (k == 2) DBG_SCAN(2, WS_QA, 375 * MiB, false);
        if (k == 3) DBG_SCAN(3, WS_QA, 115 * MiB, false);
        if (k == 4) { DBG_SCAN(4, WS_OATT, 32 * MiB, false); DBG_SCAN(12, WS_OF, 64 * MiB, false); DBG_SCAN(13, WS_OB, 64 * MiB, false); }
        if (k == 5) DBG_SCAN(5, WS_RET, 64 * MiB, false);
        if (k == 6) DBG_SCAN(6, WS_T, 64 * MiB, false);
        if (k == 7) DBG_SCAN(7, WS_MIX, 64 * MiB, false);
        if (k == 8) DBG_SCAN(8, WS_X1, 128 * MiB, true);
        if (k == 9) { DBG_SCAN(9, WS_H2, 64 * MiB, false); DBG_SCAN(9, WS_U, 128 * MiB, false); }
        if (k == 10) DBG_SCAN(10, WS_PQ, 64 * MiB, false);
        if (k == 11) DBG_SCAN(11, WS_SCT, 128 * MiB, true);
        return;
    }
#endif

    if (IN(0)) { FRESH_TID; phase0(args, lds, G, tid, lane, wave); } SEAM(0);
    if (IN(1)) {
        FRESH_TID; phase1(args, G, lane, wave); } SEAM(1);
    if (IN(2)) {
        pg8::Gemm g{1024, 1024, 1024, (const float*)(ws + WS_RS), 1.f / QW_2048}; Sched1 S{G, bx, (const char*)(ws + WS_HN), (const char*)(ws + WS_WIN)};
        pg8::EpiRoute E{(bf16_t*)(ws + WS_QA), (bf16_t*)(ws + WS_KA), (bf16_t*)(ws + WS_VA), (bf16_t*)(ws + WS_QR), (bf16_t*)(ws + WS_KR), (bf16_t*)(ws + WS_VR), (bf16_t*)(ws + WS_GR), (bf16_t*)(ws + WS_GA), (bf16_t*)(ws + WS_GT),
                        (const float*)(ws + WS_NWP), (const float*)(ws + WS_NWP) + 128, (const float*)(ws + WS_ROPE), (PG8_LAS float*)(lds + RING_BYTES)};
        pg8::gemm_phase<pg8::EpiRoute, Sched1, true, true, true>(lds, g, S, E);
        if (G == 256) {
            pg8::Gemm g2{256, 2048, 256, nullptr, 0.f}; SchedW2 S2{G, bx >= 184 ? bx - 184 : (1 << 20), (const char*)(ws + WS_KBD), (const char*)(ws + WS_WPQ)};
            pg8::EpiB<0> E2{(bf16_t*)(ws + WS_W2), 2048, nullptr, nullptr};
            pg8::gemm_phase<pg8::EpiB<0>, SchedW2, false, false>(lds, g2, S2, E2);
        }

    } SEAM(2);
    if (IN(3)) {
        { FRESH_TID; w2_quant(args, G, lane, wave); }
        const int x = bx & 7, c = bx >> 3;
        if (G == 256) {
            const int b = x >> 1, kvh = x & 1;
            float mfix; bool fixed_ok;
            { int l_ = threadIdx.x & 63; asm volatile("" : "+v"(l_)); const float wq_ = fmaxf(fabsf(args.in[8][l_]), fabsf(args.in[8][l_ + 64])), wk_ = fmaxf(fabsf(args.in[9][l_]), fabsf(args.in[9][l_ + 64]));
              mfix = 128.f * wave_max(wq_) * wave_max(wk_); mfix = __uint_as_float(__builtin_amdgcn_readfirstlane(__float_as_uint(mfix))); fixed_ok = mfix * att::SCALE < 40.f; }
#ifndef NO_ATT
            int natt = c < 16 ? 1 : 3; asm volatile("" : "+s"(natt));
#pragma unroll 1
            for (int i = 0; i < natt; ++i) { const int uu = c < 16 ? c : 16 + (c - 16) * 3 + i, h = kvh * 4 + (uu >> 4), qb = uu & 15;
                const unsigned char* q = ws + WS_QA + ((size_t)(b * SEQ + qb * 256)) * 1024 + h * 128; const unsigned char* k = ws + WS_KA + (size_t)(b * LT) * 256 + kvh * 128;
                const bf16_t* v = (const bf16_t*)(ws + WS_VA) + (size_t)(b * LT) * 256 + kvh * 128; bf16_t* o = (bf16_t*)(ws + WS_OATT) + ((size_t)(b * SEQ + qb * 256)) * 1024 + h * 128;
                asm volatile("" : "+s"(q), "+s"(k), "+s"(v), "+s"(o) :: "memory");
                if (fixed_ok) att::attn_dense_body<true>(q, k, v, o, LT, (char*)lds_raw, mfix); else att::attn_dense_body<false>(q, k, v, o, LT, (char*)lds_raw, 0.f); }
#endif
#ifndef NO_RET
            if (c < 16) {
            const int gi = x * 4 + (c >> 2), rb = gi >> 3, rh = gi & 7, dir = (c >> 1) & 1, dp = c & 1;
            ret::unit2(lds, rb, rh, dir, dp, (x * 16 + c) * 8, (const bf16_t*)(ws + WS_QR), (const bf16_t*)(ws + WS_KR), (const bf16_t*)(ws + WS_VR), (bf16_t*)(ws + (dir ? WS_OB : WS_OF)), args.in[dir ? 11 : 10][rh],
                      nullptr, args.in[19], args.in[20], ws + WS_U, ws + WS_V);
            }
#endif
        }

    } SEAM(3);
    const int team = (bx & 7) * 8 + (bx >> 5), mem = (bx >> 3) & 3;
    unsigned* tcnt = ctl + 3072 + 16 * team; bool same_xcd = false;
    if (MK_N_LAUNCHES == 1) { const unsigned b0_ = (unsigned)(bx & 7) + 32u * (unsigned)(bx >> 5); const unsigned i0 = __builtin_amdgcn_readfirstlane(ctl[2048 + b0_]), i1 = __builtin_amdgcn_readfirstlane(ctl[2048 + b0_ + 8]), i2 = __builtin_amdgcn_readfirstlane(ctl[2048 + b0_ + 16]), i3 = __builtin_amdgcn_readfirstlane(ctl[2048 + b0_ + 24]);
        same_xcd = (i0 == i1) && (i1 == i2) && (i2 == i3) && (i0 != 0u); }
#define TEAM(k, n) do { if (MK_N_LAUNCHES == 1 && IN(k)) team_barrier(ctl + CW_BAR, tcnt, 4u * (n), same_xcd); } while (0)
    const int trow0 = 256 * team + 64 * mem; int nun = 2; asm volatile("" : "+s"(nun));
    if (G != 256) return;
    if (IN(4)) { FRESH_TID; phase5(args, trow0, lane, wave); } TEAM(4, 1);
    if (IN(5)) {
        pg8::Gemm g{512, 512, 512, (const float*)(ws + WS_RS) + 32768, 1.f / QW_1024}; TeamRowSched S{team, mem, nun, (const char*)(ws + WS_OATT8), (const char*)(ws + WS_WAB), (size_t)256 * 1024, (size_t)256 * 1024};
        pg8::EpiTQ E{ws + WS_T, ws + WS_GA, (const float*)(ws + WS_RS) + 212992};
        pg8::gemm_phase<pg8::EpiTQ, TeamRowSched, true, true, true>(lds, g, S, E);
    }
    if (IN(6)) {
        pg8::Gemm g{1024, 1024, 1024, (const float*)(ws + WS_RS) + 65536, 1.f / QW_2048}; TeamRowSched S{team, mem, nun, (const char*)(ws + WS_RET), (const char*)(ws + WS_WRB), (size_t)256 * 2048, (size_t)256 * 2048};
        pg8::EpiMixQ E{ws + WS_MIXQ, ws + WS_GT, ws + WS_T, (const float*)(ws + WS_RS) + 180224, (const float*)(ws + WS_RS) + 196608};
        pg8::gemm_phase<pg8::EpiMixQ, TeamRowSched, true, true, true>(lds, g, S, E);
    } TEAM(6, 2);
    if (IN(8)) {
        pg8::Gemm g{1024, 1024, 1024, (const float*)(ws + WS_RS) + 163840, 1.f / QW_2048}; TeamRowSched S{team, mem, nun, (const char*)(ws + WS_MIXQ), (const char*)(ws + WS_WMO), (size_t)256 * 2048, (size_t)256 * 2048};
        pg8::EpiX E{(bf16_t*)(ws + WS_X1), args.in[0], (const float*)(ws + WS_CTL) + CW_MOD + 2 * 2048};
        pg8::gemm_phase<pg8::EpiX, TeamRowSched, true, true, true>(lds, g, S, E);
    } TEAM(8, 3);
    if (IN(9)) {
        FRESH_TID; phase9(args, trow0, tid, lane, wave);
    } TEAM(9, 4);
    _Float16* sct_team = (_Float16*)(ws + WS_OF) + (size_t)team * (2048 * 256);
    if (IN(10)) {
        pg8::Gemm g{1024, 1024, 1024, (const float*)(ws + WS_RS) + 98304, 1.f}; TeamKeySched S{team, mem, nun, (const char*)(ws + WS_W2Q), (const char*)(ws + WS_H2Q), (size_t)256 * 2048, (size_t)256 * 2048};
        pg8::EpiH E{sct_team, 256, (const float*)(ws + WS_RS) + 131072 + 256 * team};
        pg8::gemm_phase<pg8::EpiH, TeamKeySched, true, true, true>(lds, g, S, E);
    } TEAM(10, 5);
    if (IN(12)) { FRESH_TID; phase12(args, lds, G, tid, lane, wave, team * 4 + mem, sct_team, 64 * mem); }
#undef TEAM
#undef IN
#undef SEAM
}

extern "C" void kernel_launch(void* const* d_in, const int* in_sizes, int n_in, void* d_out, int out_size, void* d_ws, size_t ws_size, hipStream_t stream) {
    static int grid = 0;
    if (grid == 0) {
        if (n_in != 22 || in_sizes[0] != ML * DM || out_size != ML * DM || ws_size < WS_END) { fprintf(stderr, "kernel_launch: shape/workspace mismatch (n_in %d, in0 %d, out %d, ws %zu, need %zu)\n", n_in, n_in > 0 ? in_sizes[0] : -1, out_size, ws_size, (size_t)WS_END); grid = -1; return; }
        int dev = 0, cus = 0, per_cu = 0;
        if (hipGetDevice(&dev) != hipSuccess || hipDeviceGetAttribute(&cus, hipDeviceAttributeMultiprocessorCount, dev) != hipSuccess) { grid = -1; return; }
        if (hipFuncSetAttribute((const void*)mk_fwd, hipFuncAttributeMaxDynamicSharedMemorySize, LDS_BYTES) != hipSuccess) { fprintf(stderr, "kernel_launch: hipFuncSetAttribute failed\n"); grid = -1; return; }
        if (hipOccupancyMaxActiveBlocksPerMultiprocessor(&per_cu, (const void*)mk_fwd, 512, LDS_BYTES) != hipSuccess || per_cu < 1) fprintf(stderr, "kernel_launch: occupancy query reports %d\n", per_cu);
        (void)hipGetLastError();
        grid = cus < 256 ? cus : 256;
        if (grid != 256) fprintf(stderr, "kernel_launch: %d CUs; this kernel is laid out for 256\n", grid);
    }
    if (grid < 0) return;
    (void)hipMemsetAsync((char*)d_ws + WS_CTL, 0, CTL_ZERO_BYTES, stream);
    Args a{};
    for (int i = 0; i < 22; ++i) a.in[i] = (const float*)d_in[i];
    a.out = (float*)d_out; a.ws = (unsigned char*)d_ws;
    if (MK_N_LAUNCHES == 1) { a.ph_lo = 0; a.ph_hi = NPH; hipLaunchKernelGGL(mk_fwd, dim3(grid), dim3(512), LDS_BYTES, stream, a); }
    else {
#ifdef MK_DEBUG
        for (int pass = 0; pass < 2; ++pass) { a.pass = pass;
#else
        {
#endif
        for (int p = 0; p < NPH; ++p) { a.ph_lo = p; a.ph_hi = p + 1; hipLaunchKernelGGL(mk_fwd, dim3(grid), dim3(512), LDS_BYTES, stream, a);
#ifdef MK_DEBUG
            if (p < 12) { a.ph_lo = 100 + p; a.ph_hi = 101 + p; hipLaunchKernelGGL(mk_fwd, dim3(grid), dim3(512), LDS_BYTES, stream, a); }
#endif
        } }
    }
    const hipError_t le = hipPeekAtLastError();
    if (le != hipSuccess) fprintf(stderr, "kernel_launch: launch failed: %s\n", hipGetErrorName(le));
}
```
